# Optimizing an MI355X kernel written in HIP

```python
import jax, jax.numpy as jnp
from jax import lax
import numpy as np

D_MODEL = 1024
BATCH = 4
SEQ = 8192
DEPTH = 1

CHUNK = 64
N_META = 16
D_MIX = D_MODEL
D_ATTN = D_MIX // 2
HEAD_DIM = 64
N_HEADS = D_ATTN // HEAD_DIM
D_POOL = D_MIX - D_ATTN
POOL_WINDOWS = (2, 4, 8, 16)
N_POOL_GROUPS = len(POOL_WINDOWS)
POOL_GROUP_DIM = D_POOL // N_POOL_GROUPS
D_IN = 3 * D_ATTN + N_HEADS + D_POOL
D_FF = ((8 * D_MODEL + 3 * 256 - 1) // (3 * 256)) * 256
Q_BLOCK = 128
EPS = 1e-6

kernel_name = "hymba_fox_poolformer_block"


def _rmsnorm(x, w):
    x32 = x.astype(jnp.float32)
    y = x32 * lax.rsqrt(jnp.mean(x32 * x32, axis=-1, keepdims=True) + EPS)
    return (y * w.astype(jnp.float32)).astype(x.dtype)


def _forgetting_attention(q, k, v, cum_logf):
    L = q.shape[2]
    scale = HEAD_DIM ** -0.5
    outs = []
    for q0 in range(0, L, Q_BLOCK):
        q1 = min(q0 + Q_BLOCK, L)
        qb = q[:, :, q0:q1]
        kp = k[:, :, :q1]
        vp = v[:, :, :q1]
        s = jnp.einsum("bhqd,bhkd->bhqk", qb, kp).astype(jnp.float32) * scale
        s = s + (cum_logf[:, :, q0:q1, None] - cum_logf[:, :, None, :q1])
        t_idx = jnp.arange(q0, q1)[:, None]
        s_idx = jnp.arange(q1)[None, :]
        s = jnp.where(s_idx <= t_idx, s, -jnp.inf)
        p = jax.nn.softmax(s, axis=-1).astype(v.dtype)
        outs.append(jnp.einsum("bhqk,bhkd->bhqd", p, vp))
    return jnp.concatenate(outs, axis=2)


def _trailing_mean_minus_self(u, window):
    L = u.shape[1]
    cs = jnp.concatenate([jnp.zeros_like(u[:, :1]), jnp.cumsum(u, axis=1)], axis=1)
    t = jnp.arange(L)
    lo = jnp.maximum(t + 1 - window, 0)
    total = cs[:, 1:] - cs[:, lo]
    count = (t + 1 - lo).astype(jnp.float32)[None, :, None]
    return total / count - u


def _layer(h, norm1_w, w_in, b_fgate, q_norm_w, k_norm_w, w_pool, pool_scale,
           w_out, norm2_w, w_gate, w_up, w_down):
    B, L, _ = h.shape
    n1 = _rmsnorm(h, norm1_w)
    proj = n1 @ w_in.astype(h.dtype)
    q, k, v, fg, u = jnp.split(
        proj, [D_ATTN, 2 * D_ATTN, 3 * D_ATTN, 3 * D_ATTN + N_HEADS], axis=-1)

    q = _rmsnorm(q.reshape(B, L, N_HEADS, HEAD_DIM), q_norm_w).transpose(0, 2, 1, 3)
    k = _rmsnorm(k.reshape(B, L, N_HEADS, HEAD_DIM), k_norm_w).transpose(0, 2, 1, 3)
    v = v.reshape(B, L, N_HEADS, HEAD_DIM).transpose(0, 2, 1, 3)
    log_f = jax.nn.log_sigmoid((fg + b_fgate.astype(fg.dtype)).astype(jnp.float32))
    cum_logf = jnp.cumsum(log_f.transpose(0, 2, 1), axis=-1)
    a_out = _forgetting_attention(q, k, v, cum_logf)
    a_out = a_out.transpose(0, 2, 1, 3).reshape(B, L, D_ATTN)

    u32 = u.astype(jnp.float32)
    pooled = jnp.stack(
        [_trailing_mean_minus_self(u32[..., g * POOL_GROUP_DIM:(g + 1) * POOL_GROUP_DIM], w)
         for g, w in enumerate(POOL_WINDOWS)], axis=2).astype(h.dtype)
    p_out = jnp.einsum("blgc,gcd->blgd", pooled, w_pool.astype(h.dtype)).reshape(B, L, D_POOL)
    p_out = p_out * pool_scale.astype(h.dtype)

    mix = jnp.concatenate([a_out, p_out], axis=-1) @ w_out.astype(h.dtype)
    h = h + mix

    n2 = _rmsnorm(h, norm2_w)
    ffn = (jax.nn.silu(n2 @ w_gate.astype(h.dtype)) * (n2 @ w_up.astype(h.dtype))) @ w_down.astype(h.dtype)
    return h + ffn


def setup_inputs(seed: int = 0) -> dict:
    key = jax.random.key(seed)
    ks = jax.random.split(key, 16)
    x = jax.random.normal(ks[0], (BATCH, SEQ, D_MODEL), jnp.float32)
    meta_tokens = jax.random.normal(ks[1], (N_META, D_MODEL), jnp.float32)
    norm1_w = 1.0 + 0.05 * jax.random.normal(ks[2], (DEPTH, D_MODEL), jnp.float32)
    w_in = jax.random.normal(ks[3], (DEPTH, D_MODEL, D_IN), jnp.float32) * D_MODEL ** -0.5
    w_in = w_in.at[:, :, 3 * D_ATTN:3 * D_ATTN + N_HEADS].multiply(0.1)
    b_fgate = 2.0 + 2.0 * jax.random.uniform(ks[4], (DEPTH, N_HEADS), jnp.float32)
    q_norm_w = 1.0 + 0.05 * jax.random.normal(ks[5], (DEPTH, HEAD_DIM), jnp.float32)
    k_norm_w = 1.0 + 0.05 * jax.random.normal(ks[6], (DEPTH, HEAD_DIM), jnp.float32)
    w_pool = jax.random.normal(ks[7], (DEPTH, N_POOL_GROUPS, POOL_GROUP_DIM, POOL_GROUP_DIM),
                               jnp.float32) * POOL_GROUP_DIM ** -0.5
    pool_scale = 1.0 + 0.1 * jax.random.normal(ks[8], (DEPTH, D_POOL), jnp.float32)
    w_out = jax.random.normal(ks[9], (DEPTH, D_MIX, D_MODEL), jnp.float32) * D_MIX ** -0.5
    norm2_w = 1.0 + 0.05 * jax.random.normal(ks[10], (DEPTH, D_MODEL), jnp.float32)
    w_gate = jax.random.normal(ks[11], (DEPTH, D_MODEL, D_FF), jnp.float32) * D_MODEL ** -0.5
    w_up = jax.random.normal(ks[12], (DEPTH, D_MODEL, D_FF), jnp.float32) * D_MODEL ** -0.5
    w_down = jax.random.normal(ks[13], (DEPTH, D_FF, D_MODEL), jnp.float32) * D_FF ** -0.5
    return {"x": x, "meta_tokens": meta_tokens, "norm1_w": norm1_w, "w_in": w_in,
            "b_fgate": b_fgate, "q_norm_w": q_norm_w, "k_norm_w": k_norm_w,
            "w_pool": w_pool, "pool_scale": pool_scale, "w_out": w_out,
            "norm2_w": norm2_w, "w_gate": w_gate, "w_up": w_up, "w_down": w_down}


def reference(x, meta_tokens, norm1_w, w_in, b_fgate, q_norm_w, k_norm_w, w_pool,
              pool_scale, w_out, norm2_w, w_gate, w_up, w_down):
    B = x.shape[0]
    meta = jnp.broadcast_to(meta_tokens.astype(x.dtype)[None], (B, N_META, D_MODEL))
    h = jnp.concatenate([meta, x], axis=1)
    for layer in range(DEPTH):
        h = _layer(h, norm1_w[layer], w_in[layer], b_fgate[layer], q_norm_w[layer],
                   k_norm_w[layer], w_pool[layer], pool_scale[layer], w_out[layer],
                   norm2_w[layer], w_gate[layer], w_up[layer], w_down[layer])
    return h[:, N_META:]
```

```cpp
#include <hip/hip_runtime.h>
#include <hip/hip_cooperative_groups.h>
#include <cstdio>
#include <cstdint>
#include <cmath>
namespace cg = cooperative_groups;
namespace pg8 {
#define PG8_LAS __attribute__((address_space(3)))
typedef unsigned short bf16_t;
typedef short bf16x8 __attribute__((ext_vector_type(8)));
typedef float f32x4 __attribute__((ext_vector_type(4)));
typedef unsigned u32x4 __attribute__((ext_vector_type(4)));
constexpr int BM = 256, BK = 64, HALF = 128, HTB = HALF * BK * 2  , STAGE_BYTES = 8 * HTB, NXCD = 8, WGM = 8;

__host__ __device__ __forceinline__ int lds_byte(int r, int c) { const int st = (r >> 4) * 2 + (c >> 5), rr = r & 15, cc = c & 31, ob = rr * 64 + cc * 2; return st * 1024 + (ob ^ (((ob >> 9) & 1) << 5)); }
__host__ __device__ __forceinline__ void stage_rc(int b, int& R, int& C) { const int st = b / 1024, sb = b % 1024, swz = sb ^ (((sb >> 9) & 1) << 5); R = (st >> 1) * 16 + swz / 64; C = (st & 1) * 32 + (swz % 64) / 2; }
__host__ __device__ __forceinline__ int perm32(int rho) { const int n = rho >> 4, i = rho & 15; return 8 * (i >> 2) + 4 * n + (i & 3); }

struct Unit { int pm, pn; };
struct Gemm { const bf16_t* A; const bf16_t* Bt; int M, N, K; };

struct StaticOrder {
    int nM, nN, nwg, G, c, rev = 0;
    __host__ __device__ void init(int M, int N, int G_, int c_) { nM = M / BM; nN = N / BM; nwg = nM * nN; G = G_; c = c_; }
    __host__ __device__ bool next(int i, Unit& u) const {
        const int nr = (nwg - c + G - 1) / G; if (i >= nr) return false;
        const long L = (long)(rev ? nr - 1 - i : i) * G + c;
        int wgid = (int)L; { const int q = nwg / NXCD, r = nwg % NXCD, xcd = wgid % NXCD, off = wgid / NXCD; wgid = (xcd < r ? xcd * (q + 1) : r * (q + 1) + (xcd - r) * q) + off; }
        const int nig = WGM * nN, gid = wgid / nig, fm = gid * WGM, gsz = (nM - fm) < WGM ? (nM - fm) : WGM;
        u.pm = fm + ((wgid % nig) % gsz); u.pn = (wgid % nig) / gsz; return true;
    }
    __device__ __forceinline__ void a_ready(const Unit&) const {}
    __device__ __forceinline__ void done(const Unit&) const {}
};

__device__ __forceinline__ unsigned cvt_pk_bf16(float lo, float hi) { unsigned r; asm volatile("v_cvt_pk_bf16_f32 %0, %1, %2" : "=v"(r) : "v"(lo), "v"(hi)); return r; }
typedef float f32x2 __attribute__((ext_vector_type(2)));
typedef float f32x2 __attribute__((ext_vector_type(2)));
__device__ __forceinline__ u32x4 pack8(f32x4 v0, f32x4 v1) { u32x4 w; w.x = cvt_pk_bf16(v0[0], v0[1]); w.y = cvt_pk_bf16(v0[2], v0[3]); w.z = cvt_pk_bf16(v1[0], v1[1]); w.w = cvt_pk_bf16(v1[2], v1[3]); return w; }
__device__ __forceinline__ float sumsq4(f32x4 x) { return (x[0] * x[0] + x[1] * x[1]) + (x[2] * x[2] + x[3] * x[3]); }

struct EpiQKVU {
    static constexpr bool PERM = true, AFTER_DRAIN = false, HEADPERM = true;
    bf16_t *Q, *K, *V, *U; const PG8_LAS float* nwl;
    __device__ __forceinline__ void operator()(const f32x4 (&acc)[2][2][4][2], const Unit& u, int wr, int wc, int fr, int fq) const {
        const int sel = u.pn >> 1;
        bf16_t* base = sel == 0 ? Q : (sel == 1 ? K : (sel == 2 ? V : U));
        const int colb = (u.pn & 1) * 256 + wc * 64 + 8 * fq;
        const int row0 = u.pm * BM + wr * 64 + fr;
        if (sel < 2) {
            const PG8_LAS float* w = nwl + sel * 64;
            f32x4 wv[2][2];
#pragma unroll
            for (int bj = 0; bj < 2; ++bj)
#pragma unroll
                for (int n = 0; n < 2; ++n) wv[bj][n] = *(const PG8_LAS f32x4*)(w + 32 * bj + 8 * fq + 4 * n);
#pragma unroll
            for (int ai = 0; ai < 2; ++ai)
#pragma unroll
                for (int m = 0; m < 4; ++m) {
                    float ss = (sumsq4(acc[ai][0][m][0]) + sumsq4(acc[ai][0][m][1])) + (sumsq4(acc[ai][1][m][0]) + sumsq4(acc[ai][1][m][1]));
                    ss += __shfl_xor(ss, 16); ss += __shfl_xor(ss, 32);
                    const float rs = 1.0f / sqrtf(ss * (1.0f / 64.0f) + 1e-6f);
                    bf16_t* rowp = base + (size_t)(row0 + ai * HALF + m * 16) * 512 + colb;
#pragma unroll
                    for (int bj = 0; bj < 2; ++bj) *(u32x4*)(rowp + 32 * bj) = pack8(acc[ai][bj][m][0] * rs * wv[bj][0], acc[ai][bj][m][1] * rs * wv[bj][1]);
                }
        } else {
#pragma unroll
            for (int ai = 0; ai < 2; ++ai)
#pragma unroll
                for (int m = 0; m < 4; ++m) { bf16_t* rowp = base + (size_t)(row0 + ai * HALF + m * 16) * 512 + colb;
#pragma unroll
                    for (int bj = 0; bj < 2; ++bj) *(u32x4*)(rowp + 32 * bj) = pack8(acc[ai][bj][m][0], acc[ai][bj][m][1]); }
        }
    }
};

struct EpiRes1 {
    static constexpr bool PERM = true, AFTER_DRAIN = false, HEADPERM = false;
    const float* x; float* out; bf16_t* xn2; float* ssq;
    __device__ __forceinline__ void operator()(const f32x4 (&acc)[2][2][4][2], const Unit& u, int wr, int wc, int fr, int fq) const {
        const int row0 = u.pm * BM + wr * 64 + fr, col0 = u.pn * BM + wc * 32 + 8 * fq;
#pragma unroll
        for (int ai = 0; ai < 2; ++ai)
#pragma unroll
            for (int m = 0; m < 4; ++m) { const int row = row0 + ai * HALF + m * 16; const size_t off = (size_t)row * 1024 + col0; float ss = 0.f;
#pragma unroll
                for (int bj = 0; bj < 2; ++bj) {
                    const f32x4 h0 = *(const f32x4*)(x + off + bj * HALF) + acc[ai][bj][m][0], h1 = *(const f32x4*)(x + off + bj * HALF + 4) + acc[ai][bj][m][1];
                    *(u32x4*)(xn2 + off + bj * HALF) = pack8(h0, h1);
                    ss += sumsq4(h0) + sumsq4(h1); }
                ss += __shfl_xor(ss, 16); ss += __shfl_xor(ss, 32);
                if (fq == 0) ssq[(size_t)row * 16 + u.pn * 4 + wc] = ss; }
    }
};

struct EpiSwiGLU {
    static constexpr bool PERM = true, AFTER_DRAIN = false, HEADPERM = false;
    bf16_t* H; const PG8_LAS float* rstd_lds; int pmA; const float* ssq;
    __device__ __forceinline__ void operator()(const f32x4 (&acc)[2][2][4][2], const Unit& u, int wr, int wc, int fr, int fq) const {
        const int row0 = u.pm * BM + wr * 64 + fr, col0 = u.pn * HALF + wc * 32 + 8 * fq;
        const PG8_LAS float* rl = rstd_lds + (u.pm == pmA ? 0 : 256) + wr * 64 + fr;
#pragma unroll
        for (int ai = 0; ai < 2; ++ai)
#pragma unroll
            for (int m = 0; m < 4; ++m) { const int row = row0 + ai * HALF + m * 16;
                float rs;
                if (ssq) { const f32x4* sp = (const f32x4*)(ssq + (size_t)row * 16); const f32x4 s0 = sp[0], s1 = sp[1], s2 = sp[2], s3 = sp[3];
                    rs = 1.0f / sqrtf(((((s0[0] + s0[1]) + (s0[2] + s0[3])) + ((s1[0] + s1[1]) + (s1[2] + s1[3]))) + (((s2[0] + s2[1]) + (s2[2] + s2[3])) + ((s3[0] + s3[1]) + (s3[2] + s3[3])))) * (1.0f / 1024.0f) + 1e-6f); }
                else rs = rl[ai * HALF + m * 16];
                const float rsn = rs * -1.4426950408889634f, rs2 = rs * rs;
                f32x4 o[2];
#pragma unroll
                for (int n = 0; n < 2; ++n) { const f32x4 ag = acc[ai][0][m][n], t = ag * rsn;
                    f32x4 d = {__builtin_amdgcn_exp2f(t[0]), __builtin_amdgcn_exp2f(t[1]), __builtin_amdgcn_exp2f(t[2]), __builtin_amdgcn_exp2f(t[3])}; d = d + 1.0f;
                    const f32x4 r = {__builtin_amdgcn_rcpf(d[0]), __builtin_amdgcn_rcpf(d[1]), __builtin_amdgcn_rcpf(d[2]), __builtin_amdgcn_rcpf(d[3])};
                    o[n] = (ag * acc[ai][1][m][n]) * (r * rs2); }
                *(u32x4*)(H + (size_t)row * 2816 + col0) = pack8(o[0], o[1]); }
    }
};

struct EpiRes2 {
    static constexpr bool PERM = true, AFTER_DRAIN = false, HEADPERM = false;
    float* out; const bf16_t* xn2;
    __device__ __forceinline__ void operator()(const f32x4 (&acc)[2][2][4][2], const Unit& u, int wr, int wc, int fr, int fq) const {
        const int row0 = u.pm * BM + wr * 64 + fr, col0 = u.pn * BM + wc * 32 + 8 * fq;
#pragma unroll
        for (int ai = 0; ai < 2; ++ai)
#pragma unroll
            for (int m = 0; m < 4; ++m) { const size_t off = (size_t)(row0 + ai * HALF + m * 16) * 1024 + col0;
#pragma unroll
                for (int bj = 0; bj < 2; ++bj) { const u32x4 h = __builtin_nontemporal_load((const u32x4*)(xn2 + off + bj * HALF));
                    const f32x4 h0 = {__uint_as_float(h.x << 16), __uint_as_float(h.x & 0xffff0000u), __uint_as_float(h.y << 16), __uint_as_float(h.y & 0xffff0000u)};
                    const f32x4 h1 = {__uint_as_float(h.z << 16), __uint_as_float(h.z & 0xffff0000u), __uint_as_float(h.w << 16), __uint_as_float(h.w & 0xffff0000u)};
                    __builtin_nontemporal_store(h0 + acc[ai][bj][m][0], (f32x4*)(out + off + bj * HALF)); __builtin_nontemporal_store(h1 + acc[ai][bj][m][1], (f32x4*)(out + off + bj * HALF + 4)); } }
    }
};
template <class Epi, class Sched, bool ALIGN_EPI = false, bool SP2 = false, bool LIGHT = false>
__device__ __forceinline__ void gemm_phase(PG8_LAS unsigned char* lds, const Gemm g, const Sched& S, const Epi& E) {
    int tid_ = threadIdx.x; asm volatile("" : "+v"(tid_));
    const int tid = tid_, wid = __builtin_amdgcn_readfirstlane(tid >> 6), lane = tid & 63, wr = wid >> 2, wc = wid & 3, fr = lane & 15, fq = lane >> 4;
    const int K = g.K, nt = K / BK;
    unsigned voffA[2], voffB[2];
#pragma unroll
    for (int i = 0; i < 2; ++i) { int R, C; stage_rc(tid * 16 + i * 8192, R, C); const int Rb = Epi::HEADPERM ? (64 * (R >> 5) + perm32(R & 31)) : (Epi::PERM ? ((R & ~31) + perm32(R & 31)) : R);
        voffA[i] = (unsigned)(R * K + C) * 2u; voffB[i] = (unsigned)(Rb * K + C) * 2u; }
    const size_t kstep = (size_t)(BK * 2);
    const size_t hstep = (size_t)HALF * K * 2;
    const size_t hstepB = Epi::HEADPERM ? (size_t)32 * K * 2 : hstep;
    const size_t tstep = 2 * hstep;
    const unsigned ldsw = (unsigned)wid * 1024u;
    const int aoff = lds_byte(wr * 64 + fr, fq * 8), boff = lds_byte(wc * 32 + fr, fq * 8);
#define PG8_SA(b, h) (((b) * 2 + (h)) * HTB)
#define PG8_SB(b, h) ((4 + (b) * 2 + (h)) * HTB)
#define PG8_STAGE(bufoff, gbase, voff) do { _Pragma("unroll") for (int _i = 0; _i < 2; ++_i) \
        __builtin_amdgcn_global_load_lds((const unsigned*)((const char*)(gbase) + (voff)[_i]), (PG8_LAS unsigned*)(lds + (bufoff) + ldsw + _i * 8192), 16, 0, 0); } while (0)
#define PG8_LDA(dst, b, h) do { _Pragma("unroll") for (int m = 0; m < 4; ++m) _Pragma("unroll") for (int k = 0; k < 2; ++k) dst[m][k] = *(const PG8_LAS bf16x8*)(lds + PG8_SA(b, h) + aoff + m * 2048 + k * 1024); } while (0)
#define PG8_LDB(dst, b, h) do { _Pragma("unroll") for (int n = 0; n < 2; ++n) _Pragma("unroll") for (int k = 0; k < 2; ++k) dst[n][k] = *(const PG8_LAS bf16x8*)(lds + PG8_SB(b, h) + boff + n * 2048 + k * 1024); } while (0)
#define PG8_MMA(ai, bj, At, Bt) do { if constexpr (!LIGHT) { __builtin_amdgcn_s_setprio(1); _Pragma("unroll") for (int m = 0; m < 4; ++m) _Pragma("unroll") for (int n = 0; n < 2; ++n) _Pragma("unroll") for (int k = 0; k < 2; ++k) \
        acc[ai][bj][m][n] = __builtin_amdgcn_mfma_f32_16x16x32_bf16(Bt[n][k], At[m][k], acc[ai][bj][m][n], 0, 0, 0); __builtin_amdgcn_s_setprio(0); } \
    else if ((ai) == 0 && wr == 0) { _Pragma("unroll") for (int n = 0; n < 2; ++n) _Pragma("unroll") for (int k = 0; k < 2; ++k) acc[ai][bj][0][n] = __builtin_amdgcn_mfma_f32_16x16x32_bf16(Bt[n][k], At[0][k], acc[ai][bj][0][n], 0, 0, 0); } } while (0)
#define PG8_WAIT_V(n) asm volatile("s_waitcnt vmcnt(" #n ")" ::: "memory")
#define PG8_WAIT_L(n) asm volatile("s_waitcnt lgkmcnt(" #n ")" ::: "memory")
#define PG8_BAR __builtin_amdgcn_s_barrier()
#define PG8_SCHED __builtin_amdgcn_sched_barrier(0)
    Unit cur, nxt; int ui = 0;
    if (!S.next(0, cur)) return;
    f32x4 acc[2][2][4][2];
#pragma unroll
    for (int a = 0; a < 2; ++a)
#pragma unroll
        for (int b = 0; b < 2; ++b)
#pragma unroll
            for (int m = 0; m < 4; ++m)
#pragma unroll
                for (int n = 0; n < 2; ++n) acc[a][b][m][n] = (f32x4){0.f, 0.f, 0.f, 0.f};
    bf16x8 At[4][2], B0[2][2], B1[2][2];
    const char* cA = (const char*)g.A + (size_t)cur.pm * tstep; const char* cB = (const char*)g.Bt + (size_t)cur.pn * tstep;
    S.a_ready(cur);
    if constexpr (SP2) {
        PG8_STAGE(PG8_SB(0, 0), cB, voffB); PG8_STAGE(PG8_SB(0, 1), cB + hstepB, voffB); PG8_STAGE(PG8_SA(0, 0), cA, voffA); PG8_STAGE(PG8_SA(0, 1), cA + hstep, voffA);
        if (wr == 1) PG8_BAR;
        PG8_WAIT_V(2); PG8_BAR;
        PG8_STAGE(PG8_SB(1, 0), cB + kstep, voffB); PG8_STAGE(PG8_SA(1, 0), cA + kstep, voffA); PG8_STAGE(PG8_SB(1, 1), cB + hstepB + kstep, voffB);
        PG8_WAIT_V(6); PG8_BAR;
    } else {
        PG8_STAGE(PG8_SB(0, 0), cB, voffB); PG8_STAGE(PG8_SA(0, 0), cA, voffA); PG8_STAGE(PG8_SB(0, 1), cB + hstepB, voffB); PG8_STAGE(PG8_SA(0, 1), cA + hstep, voffA);
        if (wr == 1) PG8_BAR;
        PG8_WAIT_V(4); PG8_BAR;
        PG8_STAGE(PG8_SB(1, 0), cB + kstep, voffB); PG8_STAGE(PG8_SA(1, 0), cA + kstep, voffA); PG8_STAGE(PG8_SB(1, 1), cB + hstepB + kstep, voffB);
        PG8_WAIT_V(6); PG8_BAR;
    }
    for (;;) {
        const bool has_next = S.next(ui + 1, nxt);
        const char* nA = has_next ? (const char*)g.A + (size_t)nxt.pm * tstep : cA; const char* nB = has_next ? (const char*)g.Bt + (size_t)nxt.pn * tstep : cB;
        for (int t = 0; t < nt; t += 2) {
            const bool last = (t == nt - 2);
            const char* a1 = cA + (size_t)(t + 1) * kstep;
            const char* a2 = last ? nA : cA + (size_t)(t + 2) * kstep; const char* b2 = last ? nB : cB + (size_t)(t + 2) * kstep;
            const char* a3 = a2 + kstep; const char* b3 = b2 + kstep;
            if (last && has_next) S.a_ready(nxt);
            if constexpr (SP2) {
            PG8_LDB(B0, 0, 0); PG8_LDB(B1, 0, 1); PG8_SCHED; PG8_LDA(At, 0, 0); PG8_STAGE(PG8_SA(1, 1), a1 + hstep, voffA);
            PG8_WAIT_V(8); PG8_WAIT_L(0); PG8_BAR; PG8_MMA(0, 0, At, B0); PG8_MMA(0, 1, At, B1); PG8_BAR; PG8_SCHED;
            PG8_LDA(At, 0, 1); PG8_STAGE(PG8_SB(0, 0), b2, voffB); PG8_STAGE(PG8_SB(0, 1), b2 + hstepB, voffB); PG8_STAGE(PG8_SA(0, 0), a2, voffA);
            PG8_WAIT_V(8); PG8_WAIT_L(0); PG8_BAR; PG8_MMA(1, 0, At, B0); PG8_MMA(1, 1, At, B1); PG8_BAR; PG8_SCHED;
            PG8_LDB(B0, 1, 0); PG8_LDB(B1, 1, 1); PG8_SCHED; PG8_LDA(At, 1, 0); PG8_STAGE(PG8_SA(0, 1), a2 + hstep, voffA);
            PG8_WAIT_V(8); PG8_WAIT_L(0); PG8_BAR; PG8_MMA(0, 0, At, B0); PG8_MMA(0, 1, At, B1); PG8_BAR; PG8_SCHED;
            PG8_LDA(At, 1, 1); PG8_STAGE(PG8_SB(1, 0), b3, voffB); PG8_STAGE(PG8_SB(1, 1), b3 + hstepB, voffB); PG8_STAGE(PG8_SA(1, 0), a3, voffA);
            PG8_WAIT_V(8); PG8_WAIT_L(0); PG8_BAR; PG8_MMA(1, 0, At, B0); PG8_MMA(1, 1, At, B1); PG8_BAR; PG8_SCHED;
            } else {
            PG8_LDB(B0, 0, 0); PG8_SCHED; PG8_LDA(At, 0, 0); PG8_STAGE(PG8_SA(1, 1), a1 + hstep, voffA);
            PG8_WAIT_L(8); PG8_BAR; PG8_WAIT_L(0); PG8_MMA(0, 0, At, B0); PG8_BAR; PG8_SCHED;
            PG8_LDB(B1, 0, 1); PG8_STAGE(PG8_SB(0, 0), b2, voffB);
            PG8_BAR; PG8_WAIT_L(0); PG8_MMA(0, 1, At, B1); PG8_BAR;
            PG8_LDA(At, 0, 1); PG8_STAGE(PG8_SA(0, 0), a2, voffA);
            PG8_BAR; PG8_WAIT_L(0); PG8_MMA(1, 0, At, B0); PG8_BAR; PG8_SCHED;
            PG8_STAGE(PG8_SB(0, 1), b2 + hstepB, voffB);
            PG8_WAIT_V(6); PG8_BAR; PG8_MMA(1, 1, At, B1); PG8_BAR;
            PG8_LDB(B0, 1, 0); PG8_SCHED; PG8_LDA(At, 1, 0); PG8_STAGE(PG8_SA(0, 1), a2 + hstep, voffA);
            PG8_WAIT_L(8); PG8_BAR; PG8_WAIT_L(0); PG8_MMA(0, 0, At, B0); PG8_BAR; PG8_SCHED;
            PG8_LDB(B1, 1, 1); PG8_STAGE(PG8_SB(1, 0), b3, voffB);
            PG8_BAR; PG8_WAIT_L(0); PG8_MMA(0, 1, At, B1); PG8_BAR;
            PG8_LDA(At, 1, 1); PG8_STAGE(PG8_SA(1, 0), a3, voffA);
            PG8_BAR; PG8_WAIT_L(0); PG8_MMA(1, 0, At, B0); PG8_BAR; PG8_SCHED;
            PG8_STAGE(PG8_SB(1, 1), b3 + hstepB, voffB);
            PG8_WAIT_V(6); PG8_BAR; PG8_MMA(1, 1, At, B1); PG8_BAR;
            }
        }
        if constexpr (ALIGN_EPI) { if (wr == 0) PG8_BAR; }
        if constexpr (!Epi::AFTER_DRAIN) { E(acc, cur, wr, wc, fr, fq); S.done(cur); }
        if (!has_next) break;
#pragma unroll
        for (int a = 0; a < 2; ++a)
#pragma unroll
            for (int b = 0; b < 2; ++b)
#pragma unroll
                for (int m = 0; m < 4; ++m)
#pragma unroll
                    for (int n = 0; n < 2; ++n) acc[a][b][m][n] = (f32x4){0.f, 0.f, 0.f, 0.f};
        cur = nxt; cA = nA; cB = nB; ++ui;
        if constexpr (ALIGN_EPI) { if (wr == 1) PG8_BAR; }
    }
    PG8_WAIT_V(0);
    if constexpr (!ALIGN_EPI) { if (wr == 0) PG8_BAR; }
    PG8_BAR;
    if constexpr (Epi::AFTER_DRAIN) { E.fused(acc, cur, wr, wc, fr, fq, lds, wid, lane); S.done(cur); }
#undef PG8_SA
#undef PG8_SB
#undef PG8_STAGE
#undef PG8_LDA
#undef PG8_LDB
#undef PG8_MMA
#undef PG8_WAIT_V
#undef PG8_WAIT_L
#undef PG8_BAR
#undef PG8_SCHED
}
}

#include <hip/hip_bf16.h>
#include <cmath>
namespace attn_body {
using bf16=__hip_bfloat16;
using bf16x8=__attribute__((ext_vector_type(8)))short;
using s16x4=__attribute__((ext_vector_type(4)))short;
using f32x16=__attribute__((ext_vector_type(16)))float;
using u32x4=__attribute__((ext_vector_type(4)))unsigned;
constexpr int BATCH=4,NHEAD=8,SEQ=8192,D=64,DM=NHEAD*D,OPITCH=1024,MROW=BATCH*SEQ;
constexpr int NW=8,QBLK=32,QB=QBLK*NW,KVBLK=64,NQB=SEQ/QB;
constexpr int ATTN_PITCH=DM, ATTN_UNIT_ROWS=QB;
__device__ __forceinline__ int crow(int r,int hi){return (r&3)+8*(r>>2)+4*hi;}
#define SBAR() __builtin_amdgcn_sched_barrier(0)
__device__ __forceinline__ void cmask(f32x16&p0,f32x16&p1,int jb,int qrel,int hi){
  const float NEG=-INFINITY; int kb=64*jb+4*hi;
  #pragma unroll
  for(int r=0;r<16;++r){int kv=kb+(r&3)+8*(r>>2); if(kv>qrel)p0[r]=NEG; if(kv+32>qrel)p1[r]=NEG;}
}

constexpr int NSLOT=3, SLOTB=8192;
constexpr int LDS_K=0, LDS_V=NSLOT*SLOTB, LDS_WS=2*NSLOT*SLOTB, LDS_OST=LDS_WS+NW*64*4, LDS_BIAS=LDS_OST+NW*4096,LDS_BYTES=LDS_BIAS+132*64*4;
constexpr float C2=0.125f*1.4426950408889634f;
__device__ __forceinline__ void glds16(const void*gsrc,unsigned lds_dst){unsigned keep;
  asm volatile("s_mov_b32 %0, m0\n\ts_mov_b32 m0, %2\n\ts_nop 0\n\tglobal_load_lds_dwordx4 %1, off\n\ts_mov_b32 m0, %0":"=&s"(keep):"v"(gsrc),"s"(lds_dst):"memory");}
__device__ __forceinline__ float max3f(float a,float b,float c){float r;asm("v_max3_f32 %0, %1, %2, %3":"=v"(r):"v"(a),"v"(b),"v"(c));return r;}
__device__ __forceinline__ float max2f(float a,float b){float r;asm("v_max_f32_e32 %0, %1, %2":"=v"(r):"v"(a),"v"(b));return r;}
__device__ __forceinline__ float fadd_s(float a,float b){float r;asm("v_add_f32_e32 %0, %1, %2":"=v"(r):"v"(a),"v"(b));return r;}
__device__ __forceinline__ float fsub_s(float a,float b){float r;asm("v_sub_f32_e32 %0, %1, %2":"=v"(r):"v"(a),"v"(b));return r;}
typedef float f32x4_t __attribute__((ext_vector_type(4))); typedef float f32x2_t __attribute__((ext_vector_type(2))); typedef __bf16 bf16x2_t __attribute__((ext_vector_type(2)));
__device__ __forceinline__ unsigned cvtpk_s(float lo,float hi){f32x2_t v={lo,hi};bf16x2_t b=__builtin_convertvector(v,bf16x2_t);return __builtin_bit_cast(unsigned,b);}
#define WAIT_BAR(N) asm volatile("s_waitcnt vmcnt(" #N ") lgkmcnt(0)\n\ts_barrier":::"memory")

__device__ __forceinline__ void qkt(f32x16&p0,f32x16&p1,const char*Kslot,const bf16x8*qr,int r32,int hi){
  const char*kb=Kslot+hi*1024+r32*16;
  #pragma unroll
  for(int d0=0;d0<4;++d0){
    const bf16x8 b0=*reinterpret_cast<const bf16x8*>(kb+d0*2048);
    const bf16x8 b1=*reinterpret_cast<const bf16x8*>(kb+d0*2048+512);
    {p0=__builtin_amdgcn_mfma_f32_32x32x16_bf16(b0,qr[d0],p0,0,0,0);p1=__builtin_amdgcn_mfma_f32_32x32x16_bf16(b1,qr[d0],p1,0,0,0);}}
}
typedef __attribute__((address_space(3))) const char* lds_cptr;
typedef short v4i16_t __attribute__((ext_vector_type(4)));
__device__ __forceinline__ void kload8(bf16x8*kf,lds_cptr kp){
  kf[0]=*(const __attribute__((address_space(3))) bf16x8*)(kp);      kf[1]=*(const __attribute__((address_space(3))) bf16x8*)(kp+512);
  kf[2]=*(const __attribute__((address_space(3))) bf16x8*)(kp+2048); kf[3]=*(const __attribute__((address_space(3))) bf16x8*)(kp+2560);
  kf[4]=*(const __attribute__((address_space(3))) bf16x8*)(kp+4096); kf[5]=*(const __attribute__((address_space(3))) bf16x8*)(kp+4608);
  kf[6]=*(const __attribute__((address_space(3))) bf16x8*)(kp+6144); kf[7]=*(const __attribute__((address_space(3))) bf16x8*)(kp+6656);
}
__device__ __forceinline__ void kload2(bf16x8*kf,lds_cptr kp,int j){ kf[2*j]=*(const __attribute__((address_space(3))) bf16x8*)(kp+j*2048); kf[2*j+1]=*(const __attribute__((address_space(3))) bf16x8*)(kp+j*2048+512); }
__device__ __forceinline__ s16x4 vtr(lds_cptr p){ return __builtin_bit_cast(s16x4,__builtin_amdgcn_ds_read_tr16_b64_v4i16((__attribute__((address_space(3))) v4i16_t*)p)); }
__device__ __forceinline__ float rowmax(const f32x16&p0,const f32x16&p1){
  float a=max3f(p0[0],p0[1],p1[0]),b=max3f(p0[2],p0[3],p1[1]);a=max3f(a,p1[2],p1[3]);
  #pragma unroll
  for(int r=4;r<16;r+=4){a=max3f(a,p0[r],p0[r+1]);b=max3f(b,p0[r+2],p0[r+3]);a=max3f(a,p1[r],p1[r+1]);b=max3f(b,p1[r+2],p1[r+3]);}
  const float m=max2f(a,b);
  auto rr=__builtin_amdgcn_permlane32_swap(__float_as_uint(m),__float_as_uint(m),false,false);
  return max2f(__uint_as_float(rr[0]),__uint_as_float(rr[1]));
}
__device__ __forceinline__ void pv(f32x16*o,int vb,bf16x8 pa0,bf16x8 pa1,bf16x8 pa2,bf16x8 pa3){
  #pragma unroll
  for(int d0=0;d0<2;++d0){s16x4 lo[4],hi[4];
    #pragma unroll
    for(int ks=0;ks<4;++ks){
      asm volatile("ds_read_b64_tr_b16 %0,%1 offset:%c2":"=&v"(lo[ks]):"v"(vb),"i"(d0*4096+ks*1024):"memory");
      asm volatile("ds_read_b64_tr_b16 %0,%1 offset:%c2":"=&v"(hi[ks]):"v"(vb),"i"(d0*4096+ks*1024+512):"memory");}
    asm volatile("s_waitcnt lgkmcnt(0)":::"memory");SBAR();
    #define PK(k) (bf16x8){lo[k][0],lo[k][1],lo[k][2],lo[k][3],hi[k][0],hi[k][1],hi[k][2],hi[k][3]}
    o[d0]=__builtin_amdgcn_mfma_f32_32x32x16_bf16(pa0,PK(0),o[d0],0,0,0);
    o[d0]=__builtin_amdgcn_mfma_f32_32x32x16_bf16(pa1,PK(1),o[d0],0,0,0);
    o[d0]=__builtin_amdgcn_mfma_f32_32x32x16_bf16(pa2,PK(2),o[d0],0,0,0);
    o[d0]=__builtin_amdgcn_mfma_f32_32x32x16_bf16(pa3,PK(3),o[d0],0,0,0);
    #undef PK
  }
}

#ifndef ATTN_STORE16
#define ATTN_STORE16(p,v) (*(u32x4*)(p)=(v))
#endif
template<int THRL> __device__ __forceinline__ void attn_unit(int b,int h,int qb,int lo,const float*__restrict__ vb,const bf16*Q,const bf16*__restrict__ K,const bf16*__restrict__ V,bf16*O,char*shm){
  int tid_=threadIdx.x; asm volatile("":"+v"(tid_)); const int tid=tid_,lane=tid&63,r32=lane&31,hi=lane>>5; const int wid=__builtin_amdgcn_readfirstlane(tid>>6);
  const long rowbase=(long)b*SEQ; const int q0=qb*QB;
  #define TOFF(t) ((long)(((lo)+(t))<2?(long)MROW:rowbase+64L*((lo)+(t)-2))*DM)
  const bf16*Qw=Q+(rowbase+q0+wid*QBLK)*DM+h*D;
  const bf16*Kh=K+h*D,*Vh=V+h*D;
  const unsigned lds0=(unsigned)(uintptr_t)shm;
  float*wsf=(float*)(shm+LDS_WS)+wid*64;
  const bf16*ksrc=Kh+(long)lane*DM+wid*8;
  const bf16*vsrc=Vh+(long)(16*(wid&3)+(lane>>2))*DM+(wid>>2)*32+(lane&3)*8;
  const unsigned kdst=lds0+LDS_K+wid*1024, vdst=lds0+LDS_V+wid*1024;
  #define DMA_K(t,slot) glds16(ksrc+TOFF(t),(unsigned)__builtin_amdgcn_readfirstlane(kdst+(slot)))
  #define DMA_V(t,slot) glds16(vsrc+TOFF(t),(unsigned)__builtin_amdgcn_readfirstlane(vdst+(slot)))
  const int vb0=(int)(lds0+LDS_V)+((lane>>4)&1)*32+(lane&3)*8+(4*hi+((lane&15)>>2))*64;
  const char*Kbase=shm+LDS_K; bf16x8 kf[8];
  const lds_cptr shm3=(lds_cptr)shm; const lds_cptr kp0=shm3+LDS_K+hi*1024+r32*16; const lds_cptr vp0=shm3+LDS_V+((lane>>4)&1)*32+(lane&3)*8+(4*hi+((lane&15)>>2))*64;
  const int NT=4*qb+6-lo;
  for(int p_=wid;p_<((NT+3)>>2);p_+=NW) glds16(vb+(long)lo*64+p_*256+lane*4,(unsigned)__builtin_amdgcn_readfirstlane(lds0+LDS_BIAS+p_*1024));
  DMA_K(0,0);DMA_V(0,0);DMA_K(1,SLOTB);
  bf16x8 qr[4];
  #pragma unroll
  for(int d0=0;d0<4;++d0)qr[d0]=__builtin_nontemporal_load(reinterpret_cast<const bf16x8*>(&Qw[(long)r32*DM+d0*16+hi*8]));
  const lds_cptr bp0=(lds_cptr)shm+LDS_BIAS+hi*16;
  #define BLD(G,P0,P1,t) do{ if(G){ const lds_cptr bp_=bp0+(t)*256; _Pragma("unroll") for(int j_=0;j_<4;++j_){ \
      const f32x4_t b0_=*(const __attribute__((address_space(3))) f32x4_t*)(bp_+j_*32), b1_=*(const __attribute__((address_space(3))) f32x4_t*)(bp_+128+j_*32); \
      _Pragma("unroll") for(int i_=0;i_<4;++i_){ P0[4*j_+i_]=b0_[i_]; P1[4*j_+i_]=b1_[i_]; } } } }while(0)
  #define BSUB(G,P0,P1) do{ if(G){ _Pragma("unroll") for(int r_=0;r_<16;++r_){ P0[r_]-=mhat; P1[r_]-=mhat; } } }while(0)
  float mhat=0.f,l_reg=0.f;f32x16 o[2];o[0]=f32x16{};o[1]=f32x16{};
  const int qrel=wid*QBLK+r32;
  #define CMASK(P0,P1,t) do{int jb_=(t)-(NT-4); if(jb_>=0)cmask(P0,P1,jb_,qrel,hi);}while(0)
  bool resc=false;
  #define START(P0,P1) do{ const float rm=__builtin_fmaxf(rowmax(P0,P1),*(const __attribute__((address_space(3))) float*)((lds_cptr)shm+LDS_BIAS+((NT-4)*64+qrel)*4)); resc=false; \
    { const float dl=rm; mhat=fadd_s(mhat,dl); \
      _Pragma("unroll") for(int r=0;r<16;++r){P0[r]=fsub_s(P0[r],dl);P1[r]=fsub_s(P1[r],dl);} \
      } \
    _Pragma("unroll") for(int r=0;r<16;++r)P0[r]=__builtin_amdgcn_exp2f(P0[r]); }while(0)
  #define RESC() do{ if(resc){ asm volatile("s_waitcnt lgkmcnt(0)":::"memory"); \
      _Pragma("unroll") for(int d_=0;d_<2;++d_) _Pragma("unroll") for(int r=0;r<16;++r)o[d_][r]*=wsf[crow(r,hi)]; } }while(0)
  f32x16 pA0,pA1,pB0,pB1;
  int sl_prev=0,sl_cur=0,sl_next=SLOTB;
  #define ROT() do{sl_prev=sl_cur;sl_cur=sl_next;sl_next=(sl_next==(NSLOT-1)*SLOTB)?0:sl_next+SLOTB;}while(0)
  DMA_K(2,2*SLOTB);
  WAIT_BAR(3);
  BLD(true,pA0,pA1,0);qkt(pA0,pA1,Kbase,qr,r32,hi);asm volatile("s_nop 15\n\ts_nop 7":"+v"(pA0),"+v"(pA1));CMASK(pA0,pA1,0);
  START(pA0,pA1);
  _Pragma("unroll") for(int r=0;r<16;++r)pA1[r]=__builtin_amdgcn_exp2f(pA1[r]);
  BLD(true,pB0,pB1,1); BSUB(true,pB0,pB1);
  WAIT_BAR(0);
  DMA_K(3,0);DMA_V(1,SLOTB);
  ROT();
  kload8(kf,kp0+sl_cur);
  WAIT_BAR(2);
  s16x4 vlo[8],vhi[8]; u32x4 pw0,pw1,pw2,pw3;
  #define PKW(P,B) cvtpk_s(P[B],P[B+1])
  #define PAF(k) __builtin_bit_cast(bf16x8,pw##k)
  #define VFR(i) (bf16x8){vlo[i][0],vlo[i][1],vlo[i][2],vlo[i][3],vhi[i][0],vhi[i][1],vhi[i][2],vhi[i][3]}
  #define PIN(x) asm volatile("":"+v"(x))
  #define MX3(a,b,c) __builtin_fmaxf(__builtin_fmaxf((a),(b)),(c))
  #define GAPA(MF,A0,A1,A2,A3,W0,W1,PW) do{ MF; sacc+=A0; sacc+=A1; sacc+=A2; sacc+=A3; PIN(sacc); W0; W1; PIN(PW); SBAR(); }while(0)
  #define EX(v) __builtin_amdgcn_exp2f(v)
  #define GAPB(MF,X,B) do{ MF; X[B]=EX(X[B]); X[B+1]=EX(X[B+1]); X[B+2]=EX(X[B+2]); X[B+3]=EX(X[B+3]); PIN(X); SBAR(); }while(0)
  #define VRD(i) do{ vlo[i]=vtr(vp_+(((i)>>2)*4096+((i)&3)*1024)); vhi[i]=vtr(vp_+(((i)>>2)*4096+((i)&3)*1024+512)); }while(0)
  #define KRD(G,j) do{ if(G){ kload2(kf,kp0+sl_next,j); SBAR(); } }while(0)
  #define STEP(C0,C1,P0,P1,t,GK,GV,GL) do{ SBAR(); \
    const lds_cptr vp_=vp0+sl_prev; \
    VRD(0); SBAR(); float sacc=(P0[0]+P0[1]); \
    GAPA(C0=__builtin_amdgcn_mfma_f32_32x32x16_bf16(kf[0],qr[0],C0,0,0,0), P0[2],P0[3],P0[4],P0[5],     pw0[0]=PKW(P0,0), pw0[1]=PKW(P0,2), pw0); \
    VRD(4); SBAR(); GAPA(C1=__builtin_amdgcn_mfma_f32_32x32x16_bf16(kf[1],qr[0],C1,0,0,0), P0[6],P0[7],P0[8],P0[9],     pw0[2]=PKW(P0,4), pw0[3]=PKW(P0,6), pw0); \
    VRD(1); SBAR(); GAPA(C0=__builtin_amdgcn_mfma_f32_32x32x16_bf16(kf[2],qr[1],C0,0,0,0),   P0[10],P0[11],P0[12],P0[13], pw1[0]=PKW(P0,8), pw1[1]=PKW(P0,10), pw1); \
    VRD(5); SBAR(); GAPA(C1=__builtin_amdgcn_mfma_f32_32x32x16_bf16(kf[3],qr[1],C1,0,0,0),   P0[14],P0[15],P1[0],P1[1],   pw1[2]=PKW(P0,12),pw1[3]=PKW(P0,14), pw1); \
    VRD(2); SBAR(); GAPA(C0=__builtin_amdgcn_mfma_f32_32x32x16_bf16(kf[4],qr[2],C0,0,0,0),   P1[2],P1[3],P1[4],P1[5],     pw2[0]=PKW(P1,0), pw2[1]=PKW(P1,2), pw2); \
    VRD(6); SBAR(); GAPA(C1=__builtin_amdgcn_mfma_f32_32x32x16_bf16(kf[5],qr[2],C1,0,0,0),   P1[6],P1[7],P1[8],P1[9],     pw2[2]=PKW(P1,4), pw2[3]=PKW(P1,6), pw2); \
    VRD(3); SBAR(); GAPA(C0=__builtin_amdgcn_mfma_f32_32x32x16_bf16(kf[6],qr[3],C0,0,0,0),   P1[10],P1[11],P1[12],P1[13], pw3[0]=PKW(P1,8), pw3[1]=PKW(P1,10), pw3); \
    VRD(7); SBAR(); GAPA(C1=__builtin_amdgcn_mfma_f32_32x32x16_bf16(kf[7],qr[3],C1,0,0,0),   P1[14],P1[15],0.f,0.f,       pw3[2]=PKW(P1,12),pw3[3]=PKW(P1,14), pw3); \
    l_reg+=sacc; \
    if(GK){DMA_K((t)+3,sl_cur);} if(GV){DMA_V((t)+1,sl_next);} \
    CMASK(C0,C1,t); \
    { float a=MX3(C0[0],C0[1],C1[0]),b=MX3(C0[2],C0[3],C1[1]); a=MX3(a,C1[2],C1[3]); \
      _Pragma("unroll") for(int r=4;r<16;r+=4){a=MX3(a,C0[r],C0[r+1]);b=MX3(b,C0[r+2],C0[r+3]);a=MX3(a,C1[r],C1[r+1]);b=MX3(b,C1[r+2],C1[r+3]);} \
      float rm=__builtin_fmaxf(a,b); { auto rr=__builtin_amdgcn_permlane32_swap(__float_as_uint(rm),__float_as_uint(rm),false,false); rm=__builtin_fmaxf(__uint_as_float(rr[0]),__uint_as_float(rr[1])); } \
      resc=false; \
      if(__builtin_expect(__any(rm>(float)THRL),0)){ const float dl=__builtin_fmaxf(rm,0.f); mhat+=dl; \
        _Pragma("unroll") for(int r=0;r<16;++r){C0[r]-=dl;C1[r]-=dl;} \
        const float f=__builtin_amdgcn_exp2f(-dl); l_reg*=f; if(hi==0)wsf[r32]=f; resc=true; } } \
    SBAR(); BLD(GL,P0,P1,(t)+1); SBAR(); \
    GAPB(o[0]=__builtin_amdgcn_mfma_f32_32x32x16_bf16(PAF(0),VFR(0),o[0],0,0,0), C0,0); \
    GAPB(o[1]=__builtin_amdgcn_mfma_f32_32x32x16_bf16(PAF(0),VFR(4),o[1],0,0,0), C0,4); \
    KRD(GL,0); GAPB(o[0]=__builtin_amdgcn_mfma_f32_32x32x16_bf16(PAF(1),VFR(1),o[0],0,0,0), C0,8); \
    KRD(GL,1); GAPB(o[1]=__builtin_amdgcn_mfma_f32_32x32x16_bf16(PAF(1),VFR(5),o[1],0,0,0), C0,12); \
    KRD(GL,2); GAPB(o[0]=__builtin_amdgcn_mfma_f32_32x32x16_bf16(PAF(2),VFR(2),o[0],0,0,0), C1,0); \
    KRD(GL,3); GAPB(o[1]=__builtin_amdgcn_mfma_f32_32x32x16_bf16(PAF(2),VFR(6),o[1],0,0,0), C1,4); \
    GAPB(o[0]=__builtin_amdgcn_mfma_f32_32x32x16_bf16(PAF(3),VFR(3),o[0],0,0,0), C1,8); \
    GAPB(o[1]=__builtin_amdgcn_mfma_f32_32x32x16_bf16(PAF(3),VFR(7),o[1],0,0,0), C1,12); \
    BSUB(GL,P0,P1); SBAR(); \
    }while(0)
  int t=1;
  #undef CMASK
  #define CMASK(P0,P1,t) do{}while(0)
  for(;t+5<NT;t+=2){
    STEP(pB0,pB1,pA0,pA1,t,true,true,true);     WAIT_BAR(2); RESC(); ROT();
    STEP(pA0,pA1,pB0,pB1,t+1,true,true,true);   WAIT_BAR(2); RESC(); ROT();
  }
  #undef CMASK
  #define CMASK(P0,P1,t) do{int jb_=(t)-(NT-4); if(jb_>=0)cmask(P0,P1,jb_,qrel,hi);}while(0)
  #define ENDW(tt) do{ if((tt)+3<NT){WAIT_BAR(2);} else if((tt)+2<NT){WAIT_BAR(1);} else {WAIT_BAR(0);} }while(0)
  for(;t+1<NT;t+=2){
    STEP(pB0,pB1,pA0,pA1,t,(t+3<NT),(t+1<NT),(t+1<NT));       ENDW(t);   RESC(); ROT();
    STEP(pA0,pA1,pB0,pB1,t+1,(t+4<NT),(t+2<NT),(t+2<NT));     ENDW(t+1); RESC(); ROT();
  }
  STEP(pB0,pB1,pA0,pA1,NT-1,false,false,false); RESC();
  { float sacc=pB0[0]+pB0[1]; _Pragma("unroll") for(int r=2;r<16;++r)sacc+=pB0[r]; _Pragma("unroll") for(int r=0;r<16;++r)sacc+=pB1[r]; l_reg+=sacc;
    pw0=(u32x4){PKW(pB0,0),PKW(pB0,2),PKW(pB0,4),PKW(pB0,6)};pw1=(u32x4){PKW(pB0,8),PKW(pB0,10),PKW(pB0,12),PKW(pB0,14)};pw2=(u32x4){PKW(pB1,0),PKW(pB1,2),PKW(pB1,4),PKW(pB1,6)};pw3=(u32x4){PKW(pB1,8),PKW(pB1,10),PKW(pB1,12),PKW(pB1,14)};
    SBAR(); pv(o,vb0+sl_cur,PAF(0),PAF(1),PAF(2),PAF(3)); }
  #undef PKW
  #undef PAF
  #undef VFR
  #undef PIN
  #undef MX3
  #undef GAPA
  #undef GAPB
  #undef EX
  #undef VRD
  #undef KRD
  #undef STEP
  #undef ENDW
  {auto rr=__builtin_amdgcn_permlane32_swap(__float_as_uint(l_reg),__float_as_uint(l_reg),false,false);l_reg=__uint_as_float(rr[0])+__uint_as_float(rr[1]);}
  if(hi==0)wsf[32+r32]=l_reg;asm volatile("s_waitcnt lgkmcnt(0)":::"memory");
  float rli[16];
  #pragma unroll
  for(int r=0;r<16;++r)rli[r]=__builtin_amdgcn_rcpf(wsf[32+crow(r,hi)]);
  bf16*Ow=O+(rowbase+q0+wid*QBLK)*OPITCH+h*D;
  { bf16*stg=(bf16*)(shm+LDS_OST)+wid*2048;
    #pragma unroll
    for(int r=0;r<16;++r){const int orow=crow(r,hi);
      #pragma unroll
      for(int d0=0;d0<2;++d0)stg[orow*64+d0*32+r32]=__float2bfloat16(o[d0][r]*rli[r]);}
    asm volatile("s_waitcnt lgkmcnt(0)":::"memory");
    #pragma unroll
    for(int i=0;i<4;++i){const int row=i*8+(lane>>3),ch=lane&7; const u32x4 v=*(const u32x4*)(stg+row*64+ch*8); ATTN_STORE16(Ow+(long)row*OPITCH+ch*8,v);} }
  asm volatile("s_waitcnt lgkmcnt(0)\n\ts_barrier":::"memory");
  #undef DMA_K
  #undef TOFF
  #undef BLD
  #undef BSUB
  #undef DMA_V
  #undef CMASK
  #undef START
  #undef RESC
  #undef ROT
}
struct AttnTensors { const bf16* Q; const bf16* K; const bf16* V; bf16* O; const float* vb; const int* lov; unsigned* qctr; const unsigned short* U; };
constexpr int NATT=BATCH*NHEAD*NQB, NPOOL=MROW/64, LDS_NXT=LDS_BYTES, LDS_LOV=LDS_BYTES+64;
__device__ __forceinline__ void pool_tile(int p,const unsigned short*U,bf16*O,char*shm){
  typedef __attribute__((address_space(3))) u32x4 lds_v4; typedef __attribute__((address_space(3))) unsigned lds_u32;
  int tid_=threadIdx.x; asm volatile("":"+v"(tid_)); const int tid=tid_;
  const int row0=p*64, b=row0>>13, pos0=16+(row0&(SEQ-1));
  lds_v4* L=(lds_v4*)(__attribute__((address_space(3))) char*)shm;
  u32x4 v[10];
  #pragma unroll
  for(int k=0;k<10;++k){ const int i=tid+512*k; if(i<79*64){ const int r=i>>6,c=i&63,pos=pos0-15+r; const long grow=pos>=16?(long)b*SEQ+(pos-16):(long)MROW+pos; v[k]=__builtin_nontemporal_load((const u32x4*)(U+grow*DM+8*c)); } }
  #pragma unroll
  for(int k=0;k<10;++k){ const int i=tid+512*k; if(i<79*64) L[i]=v[k]; }
  __syncthreads();
  const int cp=tid&255, r0=(tid>>8)*32, w=2<<(cp>>6); const float inv=1.0f/(float)w;
  const lds_u32* Lc=(const lds_u32*)(__attribute__((address_space(3))) char*)shm+cp;
  float s0=0.f,s1=0.f;
  for(int j=1;j<w;++j){ const unsigned x=Lc[(r0+15-j)*256]; s0+=__uint_as_float(x<<16); s1+=__uint_as_float(x&0xffff0000u); }
  unsigned* outp=(unsigned*)(O+(long)(row0+r0)*OPITCH+512+2*cp);
  #pragma unroll 8
  for(int r=0;r<32;++r){ const unsigned x=Lc[(r0+r+15)*256], y=Lc[(r0+r+16-w)*256];
    const float a0=__uint_as_float(x<<16),a1=__uint_as_float(x&0xffff0000u); s0+=a0; s1+=a1;
    outp[(long)r*(OPITCH/2)]=cvtpk_s(s0*inv-a0,s1*inv-a1);
    s0-=__uint_as_float(y<<16); s1-=__uint_as_float(y&0xffff0000u); }
}
template<int THRL,class Extra> __device__ __forceinline__ void attn_phase(char*lds,const AttnTensors&T,int LPITCH,const Extra&X){
  typedef __attribute__((address_space(3))) int lds_int;
  volatile lds_int* nxt=(volatile lds_int*)((__attribute__((address_space(3))) char*)lds+LDS_NXT);
  lds_int* lovl=(lds_int*)((__attribute__((address_space(3))) char*)lds+LDS_LOV);
  for(int i=threadIdx.x;i<NATT;i+=512) lovl[i]=T.lov[i];
  __attribute__((address_space(3))) unsigned short* ordl=(__attribute__((address_space(3))) unsigned short*)((__attribute__((address_space(3))) char*)lds+LDS_LOV+4096);
  lds_int* hb=(lds_int*)((__attribute__((address_space(3))) char*)lds+LDS_LOV+4096+2048);
  lds_int* basel=hb+32*68;
  for(int i=threadIdx.x;i<32*68+68;i+=512) hb[i]=0;
  __syncthreads();
  for(int u=threadIdx.x;u<NATT;u+=512){ const int c=(4*(u&31)+6-lovl[u])>>1; __hip_atomic_fetch_add(&hb[(u>>5)*68+c],1,__ATOMIC_RELAXED,__HIP_MEMORY_SCOPE_WORKGROUP); }
  __syncthreads();
  if(threadIdx.x<68){ int run=0; for(int bh=0;bh<32;++bh){ const int t=hb[bh*68+threadIdx.x]; hb[bh*68+threadIdx.x]=run; run+=t; } basel[threadIdx.x]=run; }
  __syncthreads();
  int higher=0; if(threadIdx.x<68){ for(int c=threadIdx.x+1;c<68;++c) higher+=basel[c]; }
  __syncthreads();
  if(threadIdx.x<68) basel[threadIdx.x]=higher;
  __syncthreads();
  for(int u=threadIdx.x;u<NATT;u+=512){ const int bh=u>>5,qb=u&31,c=(4*qb+6-lovl[u])>>1; int r=basel[c]+hb[bh*68+c];
    for(int q2=0;q2<qb;++q2) r+=(((4*q2+6-lovl[bh*32+q2])>>1)==c)?1:0;
    ordl[r]=(unsigned short)u; }
  __syncthreads();
  int idx=(gridDim.x%8==0)?(int)((blockIdx.x&7)*(gridDim.x>>3)+(blockIdx.x>>3)):(int)blockIdx.x;
  while(idx<NATT+NPOOL+X.count){
    int fetched=0;
    if(threadIdx.x==0) fetched=(int)__hip_atomic_fetch_add(T.qctr,1u,__ATOMIC_RELAXED,__HIP_MEMORY_SCOPE_AGENT);
    if(idx<NATT){
      const int u_=ordl[idx], qb=u_&31, bh=u_>>5;
      const int lo=__builtin_amdgcn_readfirstlane(lovl[bh*NQB+qb]);
      attn_unit<THRL>(bh/NHEAD,bh%NHEAD,qb,lo,T.vb+(long)bh*LPITCH,T.Q,T.K,T.V,T.O,lds);
    } else if(idx<NATT+NPOOL) pool_tile(idx-NATT,T.U,T.O,lds);
    else X(idx-NATT-NPOOL);
    if(threadIdx.x==0) nxt[0]=fetched;
    asm volatile("s_waitcnt lgkmcnt(0)\n\ts_barrier":::"memory");
    idx=__builtin_amdgcn_readfirstlane(nxt[0]);
    asm volatile("s_waitcnt lgkmcnt(0)\n\ts_barrier":::"memory");
  }
}
constexpr int ATTN_LDS_BYTES=LDS_BYTES+64+4096+2048+(32*68+68)*4;
#undef SBAR
#undef WAIT_BAR
}
constexpr int NB = 4, SEQ = 8192, NMETA = 16, DM = 1024, DA = 512, NH = 8, HD = 64, DFF = 2816, DIN = 2056;
constexpr int MF = NB * SEQ;
constexpr int MP = MF + 256;
constexpr int LSEQ = NMETA + SEQ;
constexpr int LP = 8320;
constexpr float RMS_EPS = 1e-6f;
constexpr float L2E = 1.4426950408889634f;
constexpr float C2 = 0.125f * L2E;
constexpr int NWAVES = 8;
constexpr size_t MiB = 1u << 20;
constexpr size_t WS_CTL = 0, CTL_BYTES = 16384;
constexpr size_t WS_WIN = 1 * MiB;
constexpr size_t WS_WO = 5 * MiB;
constexpr size_t WS_WGU = 7 * MiB;
constexpr size_t WS_WD = 18 * MiB;
constexpr size_t WS_MISC = 24 * MiB;
constexpr size_t WS_LOGF = WS_MISC, WS_CNEG = WS_MISC + 2 * MiB, WS_LOV = WS_MISC + 4 * MiB, WS_SSQ = WS_MISC + 5 * MiB;
constexpr size_t WS_XN = 32 * MiB;
constexpr size_t WS_Q = 100 * MiB;
constexpr size_t WS_QSTRIDE = 33 * MiB;
constexpr size_t WS_A2 = 232 * MiB;
constexpr size_t WS_H = 100 * MiB;
constexpr size_t WS_END = 300 * MiB;
static_assert(WS_XN + (size_t)MP * 1024 * 2 <= WS_Q && WS_Q + 4 * WS_QSTRIDE <= WS_A2 && WS_A2 + (size_t)MF * 1024 * 2 <= WS_END && WS_H + (size_t)MF * DFF * 2 <= WS_END, "ws map");
constexpr int LDS_BYTES = 147456;

#define LAS __attribute__((address_space(3)))
typedef unsigned short bf16;
typedef unsigned v4u __attribute__((ext_vector_type(4)));
typedef float f32x4 __attribute__((ext_vector_type(4)));
__device__ __forceinline__ unsigned f2bf(float f) { unsigned u = __builtin_bit_cast(unsigned, f); return (u + 0x7fffu + ((u >> 16) & 1u)) >> 16; }
__device__ __forceinline__ unsigned pk2(float lo, float hi) { return f2bf(lo) | (f2bf(hi) << 16); }
__device__ __forceinline__ float bf2f(unsigned short b) { return __builtin_bit_cast(float, (unsigned)b << 16); }
__device__ __forceinline__ float sumsq4f(f32x4 x) { return (x[0] * x[0] + x[1] * x[1]) + (x[2] * x[2] + x[3] * x[3]); }
__device__ __forceinline__ float wave_sum(float v) {
#pragma unroll
    for (int o = 1; o < 64; o <<= 1) v += __shfl_xor(v, o);
    return v;
}
__device__ __forceinline__ float wave_max(float v) {
#pragma unroll
    for (int o = 1; o < 64; o <<= 1) v = fmaxf(v, __shfl_xor(v, o));
    return v;
}
__device__ __forceinline__ int pos_row(int b, int pos) { return pos >= NMETA ? b * SEQ + (pos - NMETA) : MF + pos; }

__device__ __forceinline__ void p0_transpose_item(const float* W, int ldw, int k0, int srccol, bf16* WT, int ldwt, int wtrow0, int wtcol0, const float* kscale, LAS float* scr, int lane) {
#pragma unroll
    for (int i = 0; i < 32; ++i) { const int kk = 2 * i + (lane >> 5); float v = __builtin_nontemporal_load(W + (size_t)(k0 + kk) * ldw + srccol + (lane & 31)); if (kscale) v *= kscale[k0 + kk]; scr[kk * 33 + (lane & 31)] = v; }
    asm volatile("s_waitcnt lgkmcnt(0)" ::: "memory");
    const int c = lane & 7;
#pragma unroll
    for (int j = 0; j < 4; ++j) { const int n = (lane >> 3) + 8 * j; const LAS float* s = scr + (8 * c) * 33 + n;
        v4u o; o.x = pk2(s[0 * 33], s[1 * 33]); o.y = pk2(s[2 * 33], s[3 * 33]); o.z = pk2(s[4 * 33], s[5 * 33]); o.w = pk2(s[6 * 33], s[7 * 33]);
        *(v4u*)(WT + (size_t)(wtrow0 + n) * ldwt + wtcol0 + 8 * c) = o; }
    asm volatile("s_waitcnt lgkmcnt(0)" ::: "memory");
}

struct ConvItems {
    static constexpr int I_G = 16 * 88, I_D = 44 * 32, I_F = 4 * 8 * 16, NW_ITEMS = 2 * I_G + I_D + I_F;
    int count; LAS unsigned char* lds;
    const float *w_gate, *w_up, *w_down, *w_out, *w_pool, *pool_scale, *norm2_w; bf16 *Wgu_t, *Wd_t, *Wo_t;
    __device__ __forceinline__ void operator()(int item) const { int tid_ = threadIdx.x; asm volatile("" : "+v"(tid_)); wave_item(item * 8 + __builtin_amdgcn_readfirstlane(tid_ >> 6)); }
    __device__ __forceinline__ void wave_item(int r) const {
        int tid_ = threadIdx.x; asm volatile("" : "+v"(tid_));
        const int lane = tid_ & 63, wave = __builtin_amdgcn_readfirstlane(tid_ >> 6);
        LAS float* scr = (LAS float*)(lds + wave * 8704);
        if (r >= NW_ITEMS) return;
        if (r < I_F) {
            const int g = r >> 7, cb = (r >> 4) & 7, db = r & 15, d = db * 64 + lane, c0 = cb * 16;
            const float* wp = w_pool + ((size_t)g * 128 + c0) * 128;
#pragma unroll 8
            for (int t = 0; t < 32; ++t) { const int idx = t * 64 + lane, c = idx >> 7, j = idx & 127; scr[j * 16 + c] = wp[c * 128 + j] * pool_scale[128 * g + j]; }
            asm volatile("s_waitcnt lgkmcnt(0)" ::: "memory");
            f32x4 a[4];
#pragma unroll
            for (int i = 0; i < 4; ++i) a[i] = (f32x4){0.f, 0.f, 0.f, 0.f};
            const float* wo = w_out + (size_t)(512 + 128 * g) * 1024 + d;
#pragma unroll 16
            for (int j = 0; j < 128; ++j) { const float wv = wo[(size_t)j * 1024]; const LAS f32x4* s4 = (const LAS f32x4*)(scr + j * 16);
#pragma unroll
                for (int i = 0; i < 4; ++i) a[i] += s4[i] * wv; }
            v4u o0, o1; o0.x = pk2(a[0][0], a[0][1]); o0.y = pk2(a[0][2], a[0][3]); o0.z = pk2(a[1][0], a[1][1]); o0.w = pk2(a[1][2], a[1][3]);
            o1.x = pk2(a[2][0], a[2][1]); o1.y = pk2(a[2][2], a[2][3]); o1.z = pk2(a[3][0], a[3][1]); o1.w = pk2(a[3][2], a[3][3]);
            v4u* op = (v4u*)(Wo_t + (size_t)d * 1024 + 512 + 128 * g + c0); op[0] = o0; op[1] = o1;
            asm volatile("s_waitcnt lgkmcnt(0)" ::: "memory");
            return; } r -= I_F;
        if (r < 2 * I_G) { const int up = r >= I_G; if (up) r -= I_G; const int kb = r / 88, nb = r % 88, n0 = 32 * nb;
            p0_transpose_item(up ? w_up : w_gate, DFF, 64 * kb, n0, Wgu_t, 1024, (n0 >> 7) * 256 + (n0 & 127) + (up ? 128 : 0), 64 * kb, norm2_w, scr, lane); return; } r -= 2 * I_G;
        { const int kb = r / 32, nb = r % 32; p0_transpose_item(w_down, 1024, 64 * kb, 32 * nb, Wd_t, DFF, 32 * nb, 64 * kb, nullptr, scr, lane); }
    }
};

#define RLX_AGENT __ATOMIC_RELAXED, __HIP_MEMORY_SCOPE_AGENT
#define XB_TMO      128
#define XB_XCNT(j)  (256  + 64 * (j))
#define XB_XSUB(j)  (1280 + 64 * (j))
#define XB_XGEN(j)  (2304 + 64 * (j))
#define XB_TOP      3328
#define XB_TOPGEN   3392
#define XCD_BAR_WORDS 3456
#define XB_SPIN_CAP (1u << 18)

__device__ __forceinline__ unsigned xb_ld(unsigned* p)              { return __hip_atomic_load(p, __ATOMIC_RELAXED, __HIP_MEMORY_SCOPE_AGENT); }
__device__ __forceinline__ unsigned xb_add(unsigned* p, unsigned v) { return __hip_atomic_fetch_add(p, v, __ATOMIC_RELAXED, __HIP_MEMORY_SCOPE_AGENT); }
__device__ __forceinline__ unsigned xb_xcc_id() { return (unsigned)__builtin_amdgcn_s_getreg((3 << 11) | 20) & 0xFu; }
#define XB_SPIN(cond, bar) do { unsigned _sp = 0; while (cond) { __builtin_amdgcn_s_sleep(1); \
    if ((++_sp & 255u) == 0u) { if (xb_ld(&(bar)[XB_TMO])) break; if (_sp > XB_SPIN_CAP) { atomicAdd(&(bar)[XB_TMO], 1u); break; } } } } while (0)

struct XcdBarrier {
    unsigned* bar; unsigned x;
    volatile LAS unsigned* st;
};

__device__ __forceinline__ XcdBarrier xcd_barrier_post(unsigned* bar, volatile LAS unsigned* st) {
    XcdBarrier b; b.bar = bar; b.x = xb_xcc_id(); b.st = st;
    if (threadIdx.x == 0) (void)xb_add(&bar[XB_XCNT(b.x)], 1u);
    return b;
}
__device__ __forceinline__ void xcd_barrier_complete(unsigned* bar, unsigned x, unsigned& nloc, unsigned& nx) {
    const unsigned G = gridDim.x * gridDim.y * gridDim.z;
    unsigned sum, cnt, mine, sp = 0u;
    for (;;) {
        sum = 0u; cnt = 0u; mine = 0u;
#pragma unroll
        for (unsigned j = 0; j < 16; ++j) { const unsigned c = xb_ld(&bar[XB_XCNT(j)]); sum += c; cnt += (c > 0u) ? 1u : 0u; mine = (j == x) ? c : mine; }
        if (sum == G) break;
        __builtin_amdgcn_s_sleep(1);
        if ((++sp & 255u) == 0u) { if (xb_ld(&bar[XB_TMO])) break; if (sp > XB_SPIN_CAP) { atomicAdd(&bar[XB_TMO], 1u); break; } }
    }
    nloc = mine > 0u ? mine : 1u; nx = cnt > 0u ? cnt : 1u;
}

__device__ __forceinline__ void xcd_barrier(const XcdBarrier& b) {
    asm volatile("s_waitcnt vmcnt(0)" ::: "memory");
    __syncthreads();
    if (threadIdx.x == 0) {
        unsigned* bar = b.bar;
        __builtin_amdgcn_s_waitcnt(0);
        unsigned nloc = b.st[0], nx = b.st[1];
        if (nloc == 0u) { xcd_barrier_complete(bar, b.x, nloc, nx); b.st[0] = nloc; b.st[1] = nx; }
        const unsigned old = xb_add(&bar[XB_XSUB(b.x)], 1u);
        const unsigned gen = old / nloc;
        if (old + 1u == (gen + 1u) * nloc) {
            __builtin_amdgcn_fence(__ATOMIC_RELEASE, "agent");
            asm volatile("s_waitcnt vmcnt(0)" ::: "memory");
            const unsigned og = xb_add(&bar[XB_TOP], 1u);
            const unsigned tg = og / nx;
            if (og + 1u == (tg + 1u) * nx) xb_add(&bar[XB_TOPGEN], 1u);
            else XB_SPIN(xb_ld(&bar[XB_TOPGEN]) == tg, bar);
            __builtin_amdgcn_fence(__ATOMIC_ACQUIRE, "agent");
            xb_add(&bar[XB_XGEN(b.x)], 1u);
            asm volatile("s_waitcnt vmcnt(0)" ::: "memory");
        } else {
            XB_SPIN(xb_ld(&bar[XB_XGEN(b.x)]) == gen, bar);
            __builtin_amdgcn_fence(__ATOMIC_ACQUIRE, "agent");
            asm volatile("s_waitcnt vmcnt(0)" ::: "memory");
        }
    }
    __syncthreads();
}

struct NoExtra { int count; __device__ __forceinline__ void operator()(int) const {} };
#ifndef PROBE_REP
#define PROBE_REP -1
#endif
#define REPS(k) for (int rep_ = 0; rep_ < ((PROBE_REP) == (k) ? 2 : 1); ++rep_)
struct Args { const float* in[14]; float* out; unsigned char* ws; int never; int pad; };

__global__ void __launch_bounds__(NWAVES * 64, 2) hymba_fwd(Args args) {
    extern __shared__ __attribute__((aligned(16))) unsigned char lds_raw[];
    cg::grid_group grid = cg::this_grid();
    LAS unsigned char* lds = (LAS unsigned char*)lds_raw;
    const int tid = threadIdx.x, lane = tid & 63, wave = __builtin_amdgcn_readfirstlane(tid >> 6);
    const int G = gridDim.x, bx = blockIdx.x;
    const int vcu = (G % 8 == 0) ? (bx % 8) * (G / 8) + bx / 8 : bx;
    const int gw = vcu * NWAVES + wave, NGW = G * NWAVES;
    const float* x = args.in[0]; const float* meta = args.in[1]; const float* norm1_w = args.in[2]; const float* w_in = args.in[3]; const float* b_fgate = args.in[4];
    const float* q_norm_w = args.in[5]; const float* k_norm_w = args.in[6]; const float* w_pool = args.in[7]; const float* pool_scale = args.in[8]; const float* w_out = args.in[9];
    const float* norm2_w = args.in[10]; const float* w_gate = args.in[11]; const float* w_up = args.in[12]; const float* w_down = args.in[13];
    float* out = args.out; unsigned char* ws = args.ws;
    volatile LAS unsigned* bst = (volatile LAS unsigned*)(lds + LDS_BYTES - 64);
    if (tid < 2) bst[tid] = 0u;
    __syncthreads();
    const XcdBarrier bar = xcd_barrier_post((unsigned*)(ws + WS_CTL), bst);
    if (args.never) grid.sync();
#define GSYNC() xcd_barrier(bar)
    bf16* Win_t = (bf16*)(ws + WS_WIN); bf16* Wo_t = (bf16*)(ws + WS_WO); bf16* Wgu_t = (bf16*)(ws + WS_WGU); bf16* Wd_t = (bf16*)(ws + WS_WD);
    float* logf_ = (float*)(ws + WS_LOGF); float* cneg = (float*)(ws + WS_CNEG); int* lov = (int*)(ws + WS_LOV); unsigned* qctr = (unsigned*)(ws + WS_LOV + 65536); float* ssq = (float*)(ws + WS_SSQ);
    bf16* XN = (bf16*)(ws + WS_XN); bf16* Qb = (bf16*)(ws + WS_Q); bf16* Kb = (bf16*)(ws + WS_Q + WS_QSTRIDE); bf16* Vb = (bf16*)(ws + WS_Q + 2 * WS_QSTRIDE); bf16* Ub = (bf16*)(ws + WS_Q + 3 * WS_QSTRIDE);
    bf16* A2 = (bf16*)(ws + WS_A2); bf16* Hb = (bf16*)(ws + WS_H);

    REPS(0) {
        if (bx == 0 && tid == 0) { qctr[0] = (unsigned)G; qctr[64] = (unsigned)G; }
        LAS float* scr = (LAS float*)(lds + wave * 8704);
        constexpr int I_QKV = 16 * 48, I_U = 16 * 16, I_O = 8 * 32;
        for (int it = gw; it < I_QKV + I_U + I_O; it += NGW) {
            int r = it;
            if (r < I_QKV) { const int kb = r / 48, nb = r % 48; p0_transpose_item(w_in, DIN, 64 * kb, 32 * nb, Win_t, 1024, 32 * nb, 64 * kb, nullptr, scr, lane); continue; } r -= I_QKV;
            if (r < I_U) { const int kb = r / 16, nb = r % 16; p0_transpose_item(w_in, DIN, 64 * kb, 1544 + 32 * nb, Win_t, 1024, 1536 + 32 * nb, 64 * kb, nullptr, scr, lane); continue; } r -= I_U;
            { const int kb = r / 32, nb = r % 32; p0_transpose_item(w_out, 1024, 64 * kb, 32 * nb, Wo_t, 1024, 32 * nb, 64 * kb, nullptr, scr, lane); }
        }
        {
            LAS f32x4* wft = (LAS f32x4*)(lds + 73728);
            for (int k = tid; k < DM; k += NWAVES * 64) { const float s = norm1_w[k]; const f32x4 a = *(const f32x4*)(w_in + (size_t)k * DIN + 1536) * s, b = *(const f32x4*)(w_in + (size_t)k * DIN + 1540) * s;
                const int e = ((4 * (k >> 8) + (k & 3)) * 2) * 64 + ((k & 255) >> 2); wft[e] = a; wft[e + 64] = b; }
            __syncthreads();
            f32x4 nw[4];
#pragma unroll
            for (int j = 0; j < 4; ++j) nw[j] = *(const f32x4*)(norm1_w + 4 * lane + 256 * j);
            const float bfg = b_fgate[lane & 7];
            f32x4 vn[4], vn2[4];
            { const int m = gw; const float* xrow = m < MF ? x + (size_t)m * DM : meta + (size_t)(m - MF) * DM;
#pragma unroll
              for (int j = 0; j < 4; ++j) vn[j] = __builtin_nontemporal_load((const f32x4*)(xrow + 4 * lane + 256 * j));
              const int m2 = gw + NGW; if (m2 < MF + NMETA) { const float* xrow2 = m2 < MF ? x + (size_t)m2 * DM : meta + (size_t)(m2 - MF) * DM;
#pragma unroll
                for (int j = 0; j < 4; ++j) vn2[j] = __builtin_nontemporal_load((const f32x4*)(xrow2 + 4 * lane + 256 * j)); } }
            for (int m = gw; m < MF + NMETA; m += NGW) {
                f32x4 v[4]; float ss = 0.f;
#pragma unroll
                for (int j = 0; j < 4; ++j) { v[j] = vn[j]; vn[j] = vn2[j]; ss += sumsq4f(v[j]); }
                { const int mn = m + 2 * NGW; if (mn < MF + NMETA) { const float* xrow = mn < MF ? x + (size_t)mn * DM : meta + (size_t)(mn - MF) * DM;
#pragma unroll
                    for (int j = 0; j < 4; ++j) vn2[j] = __builtin_nontemporal_load((const f32x4*)(xrow + 4 * lane + 256 * j)); } }
                const float rstd = 1.0f / sqrtf(wave_sum(ss) * (1.0f / DM) + RMS_EPS);
                unsigned long long* o8 = (unsigned long long*)(XN + (size_t)m * DM) + lane;
#pragma unroll
                for (int j = 0; j < 4; ++j) { const f32x4 y = v[j] * rstd * nw[j]; o8[64 * j] = (unsigned long long)pk2(y[0], y[1]) | ((unsigned long long)pk2(y[2], y[3]) << 32); }
                f32x4 a0 = {0.f, 0.f, 0.f, 0.f}, a1 = {0.f, 0.f, 0.f, 0.f};
#pragma unroll
                for (int j = 0; j < 4; ++j)
#pragma unroll
                    for (int i = 0; i < 4; ++i) { a0 += wft[((4 * j + i) * 2) * 64 + lane] * v[j][i]; a1 += wft[((4 * j + i) * 2 + 1) * 64 + lane] * v[j][i]; }
                float fgsel = 0.f;
#pragma unroll
                for (int h = 0; h < 8; ++h) { const float a = wave_sum(h < 4 ? a0[h & 3] : a1[h & 3]); if ((lane & 7) == h) fgsel = a; }
                const float z = fgsel * rstd + bfg;
                const float lf = fminf(z, 0.f) - log1pf(expf(-fabsf(z)));
                if (lane < 8) {
                    if (m < MF) { const int b = m >> 13, t = m & (SEQ - 1); logf_[(size_t)(b * NH + lane) * LP + NMETA + t] = lf; }
                    else { for (int b = 0; b < NB; ++b) logf_[(size_t)(b * NH + lane) * LP + (m - MF)] = lf; }
                }
            }
        }
        GSYNC();
    }

    REPS(1) {
    for (int hh = bx; hh < 24; hh += G) {
        typedef short bf16x8_t __attribute__((ext_vector_type(8)));
        const int fr = lane & 15, fq = lane >> 4, nbase = 512 + 64 * hh;
        f32x4 acc4[4];
#pragma unroll
        for (int nb = 0; nb < 4; ++nb) acc4[nb] = (f32x4){0.f, 0.f, 0.f, 0.f};
#pragma unroll
        for (int s_ = 0; s_ < 4; ++s_) { const int k0 = 128 * wave + 32 * s_ + 8 * fq;
            const bf16x8_t av = *(const bf16x8_t*)(XN + (size_t)(MF + fr) * DM + k0);
#pragma unroll
            for (int nb = 0; nb < 4; ++nb) { const bf16x8_t bv = *(const bf16x8_t*)(Win_t + (size_t)(nbase + 16 * nb + fr) * DM + k0); acc4[nb] = __builtin_amdgcn_mfma_f32_16x16x32_bf16(bv, av, acc4[nb], 0, 0, 0); } }
        LAS float* part = (LAS float*)lds;
#pragma unroll
        for (int nb = 0; nb < 4; ++nb)
#pragma unroll
            for (int j = 0; j < 4; ++j) part[(wave * 16 + fr) * 64 + 16 * nb + 4 * fq + j] = acc4[nb][j];
        __syncthreads();
        const int row = tid >> 5, c = 2 * (tid & 31);
        float v0 = 0.f, v1 = 0.f;
#pragma unroll
        for (int w = 0; w < 8; ++w) { v0 += part[(w * 16 + row) * 64 + c]; v1 += part[(w * 16 + row) * 64 + c + 1]; }
        bf16* dstb = hh < 8 ? Kb : (hh < 16 ? Vb : Ub); const int colb = 64 * (hh & 7);
        if (hh < 8) { float ss = v0 * v0 + v1 * v1;
#pragma unroll
            for (int o = 1; o < 32; o <<= 1) ss += __shfl_xor(ss, o);
            const float rs = 1.0f / sqrtf(ss * (1.0f / 64.0f) + RMS_EPS); v0 *= rs * k_norm_w[c]; v1 *= rs * k_norm_w[c + 1]; }
        *(unsigned*)(dstb + (size_t)(MF + row) * 512 + colb + c) = pk2(v0, v1);
        for (int i = tid; i < 48 * 32; i += NWAVES * 64) *(unsigned*)(dstb + (size_t)(MF + 16 + (i >> 5)) * 512 + colb + 2 * (i & 31)) = 0u;
        __syncthreads();
    }
    if (bx >= G - NB * NH && G >= NB * NH) {
        const int bh = bx - (G - NB * NH);
        LAS float* buf = (LAS float*)lds; LAS float* wtot = (LAS float*)(lds + 36864);
        const float* src = logf_ + (size_t)bh * LP;
        for (int i = tid; i < 8704; i += 512) buf[i] = i < LSEQ ? src[i] : 0.f;
        __syncthreads();
        float s = 0.f;
#pragma unroll
        for (int i = 0; i < 17; ++i) s += buf[17 * tid + i];
        float inc = s;
#pragma unroll
        for (int o = 1; o < 64; o <<= 1) { const float t = __shfl_up(inc, o); if (lane >= o) inc += t; }
        if (lane == 63) wtot[wave] = inc;
        __syncthreads();
        float run = inc - s;
        for (int w = 0; w < wave; ++w) run += wtot[w];
#pragma unroll
        for (int i = 0; i < 17; ++i) { run += buf[17 * tid + i]; buf[17 * tid + i] = -L2E * run; }
        __syncthreads();
        float* dst = cneg + (size_t)bh * LP;
        for (int i = tid; i < LP; i += 512) dst[i] = i < NMETA ? buf[i] : (i < 128 ? -INFINITY : buf[i - 112]);
        if (tid < 32) {
            float mq = 0.f, mk = 0.f;
            for (int i = 0; i < 64; ++i) { mq = fmaxf(mq, fabsf(q_norm_w[i])); mk = fmaxf(mk, fabsf(k_norm_w[i])); }
            const float T2 = 2.0f * (L2E * 8.0f * mq * mk) + 24.0f;
            const int qb = tid, NT = 2 + 4 * (qb + 1); const float ref = buf[NMETA + 256 * qb];
            int lo = 0;
            if (buf[NMETA - 1] - ref < -T2) { int v = 2, hi_ = NT - 4;
                while (v < hi_) { const int mid = (v + hi_) >> 1; if (buf[NMETA + 64 * (mid - 2) + 63] - ref < -T2) v = mid + 1; else hi_ = mid; }
                lo = v & ~1; }
            lov[bh * 32 + qb] = lo;
        }
        __syncthreads();
    }
    {
        pg8::Gemm g{XN, Win_t, MF, 2048, 1024}; pg8::StaticOrder S; S.init(MF, 2048, G, bx);
        LAS float* nwl = (LAS float*)(lds + 131072);
        if (tid < 128) nwl[tid] = tid < 64 ? q_norm_w[tid] * C2 : k_norm_w[tid - 64];
        __syncthreads();
        pg8::EpiQKVU E{Qb, Kb, Vb, Ub, nwl};
        pg8::gemm_phase<pg8::EpiQKVU, pg8::StaticOrder, true, true>(lds, g, S, E);
    }
    GSYNC();
    }

    REPS(2) {
    {
        static_assert(attn_body::ATTN_LDS_BYTES <= LDS_BYTES, "attention LDS");
        const attn_body::AttnTensors AT{(const attn_body::bf16*)Qb, (const attn_body::bf16*)Kb, (const attn_body::bf16*)Vb, (attn_body::bf16*)A2, cneg, lov, qctr + 64 * rep_, (const unsigned short*)Ub};
        ConvItems CI{(ConvItems::NW_ITEMS + 7) / 8, lds, w_gate, w_up, w_down, w_out, w_pool, pool_scale, norm2_w, Wgu_t, Wd_t, Wo_t};
        if (gw < ConvItems::I_F && NGW > 2 * ConvItems::I_F) { CI.wave_item(gw); CI.wave_item(ConvItems::I_F + gw); }
        else if (NGW > 2 * ConvItems::I_F) { for (int r = 2 * ConvItems::I_F + (gw - ConvItems::I_F); r < ConvItems::NW_ITEMS; r += NGW - ConvItems::I_F) CI.wave_item(r); }
        else { for (int r = gw; r < ConvItems::NW_ITEMS; r += NGW) CI.wave_item(r); }
        __syncthreads();
        const NoExtra NX{0};
        attn_body::attn_phase<32, NoExtra>((char*)lds_raw, AT, LP, NX);
    }
    GSYNC();
    }

    REPS(3) {
        pg8::Gemm g{A2, Wo_t, MF, 1024, 1024}; pg8::StaticOrder S; S.init(MF, 1024, G, bx);
        pg8::EpiRes1 E{x, out, XN, ssq};
        pg8::gemm_phase<pg8::EpiRes1, pg8::StaticOrder, true, true>(lds, g, S, E);
        GSYNC();
    }
    REPS(4) {
        pg8::Gemm g{XN, Wgu_t, MF, 2 * DFF, 1024}; pg8::StaticOrder S; S.init(MF, 2 * DFF, G, bx);
        LAS float* rstd_lds = (LAS float*)(lds + 131072);
        int pmA = -1, pmB = -1; bool many = false; { pg8::Unit u_; for (int i_ = 0; S.next(i_, u_); ++i_) { if (pmA < 0) pmA = u_.pm; if (u_.pm != pmA) { if (pmB < 0) pmB = u_.pm; else if (u_.pm != pmB) many = true; } } }
        if (pmA >= 0) { const int pm_ = (tid < 256 || pmB < 0) ? pmA : pmB; const f32x4* sp = (const f32x4*)(ssq + ((size_t)pm_ * 256 + (tid & 255)) * 16); const f32x4 s0 = sp[0], s1 = sp[1], s2 = sp[2], s3 = sp[3];
            const float tot = (((s0[0] + s0[1]) + (s0[2] + s0[3])) + ((s1[0] + s1[1]) + (s1[2] + s1[3]))) + (((s2[0] + s2[1]) + (s2[2] + s2[3])) + ((s3[0] + s3[1]) + (s3[2] + s3[3])));
            rstd_lds[tid] = 1.0f / sqrtf(tot * (1.0f / 1024.0f) + RMS_EPS); }
        __syncthreads();
        pg8::EpiSwiGLU E{Hb, rstd_lds, pmA, many ? ssq : nullptr};
        pg8::gemm_phase<pg8::EpiSwiGLU, pg8::StaticOrder, true, true>(lds, g, S, E);
        GSYNC();
    }
    {
        pg8::Gemm g{Hb, Wd_t, MF, 1024, DFF}; pg8::StaticOrder S; S.init(MF, 1024, G, bx);
        pg8::EpiRes2 E{out, XN};
        pg8::gemm_phase<pg8::EpiRes2, pg8::StaticOrder, true, true>(lds, g, S, E);
    }
}

extern "C" void kernel_launch(void* const* d_in, const int* in_sizes, int n_in, void* d_out, int out_size, void* d_ws, size_t ws_size, hipStream_t stream) {
    static int grid = 0;
    if (grid == 0) {
        if (n_in != 14 || in_sizes[0] != MF * DM || out_size != MF * DM || ws_size < WS_END) { fprintf(stderr, "kernel_launch: unexpected shapes (n_in %d, in0 %d, out %d, ws %zu); nothing launched\n", n_in, n_in > 0 ? in_sizes[0] : -1, out_size, ws_size); grid = -1; return; }
        int dev = 0, cus = 0, per_cu = 0;
        hipGetDevice(&dev); hipDeviceGetAttribute(&cus, hipDeviceAttributeMultiprocessorCount, dev);
        if (hipFuncSetAttribute((const void*)hymba_fwd, hipFuncAttributeMaxDynamicSharedMemorySize, LDS_BYTES) != hipSuccess) { fprintf(stderr, "kernel_launch: hipFuncSetAttribute failed\n"); }
        if (hipOccupancyMaxActiveBlocksPerMultiprocessor(&per_cu, (const void*)hymba_fwd, NWAVES * 64, LDS_BYTES) != hipSuccess || per_cu < 1) { fprintf(stderr, "kernel_launch: occupancy query says %d blocks per CU\n", per_cu); per_cu = 1; }
        (void)hipGetLastError();
        grid = cus * per_cu;
    }
    if (grid < 0) return;
    if (hipMemsetAsync((char*)d_ws + WS_CTL, 0, CTL_BYTES, stream) != hipSuccess) { fprintf(stderr, "kernel_launch: hipMemsetAsync failed\n"); return; }
    Args a{};
    for (int i = 0; i < 14; ++i) a.in[i] = (const float*)d_in[i];
    a.out = (float*)d_out; a.ws = (unsigned char*)d_ws;
    void* kargs[] = {&a};
    hipError_t e = hipLaunchCooperativeKernel((const void*)hymba_fwd, dim3(grid), dim3(NWAVES * 64), kargs, LDS_BYTES, stream);
    if (e != hipSuccess) fprintf(stderr, "kernel_launch: cooperative launch failed: %s (grid %d)\n", hipGetErrorString(e), grid);
}
```

```cpp
#include <hip/hip_runtime.h>
#include <hip/hip_cooperative_groups.h>
#include <cstdio>
#include <cstdint>
#include <cmath>
namespace cg = cooperative_groups;
namespace pg8 {
#define PG8_LAS __attribute__((address_space(3)))
typedef unsigned short bf16_t;
typedef short bf16x8 __attribute__((ext_vector_type(8)));
typedef float f32x4 __attribute__((ext_vector_type(4)));
typedef unsigned u32x4 __attribute__((ext_vector_type(4)));
constexpr int BM = 256, BK = 64, HALF = 128, HTB = HALF * BK * 2  , STAGE_BYTES = 8 * HTB, NXCD = 8, WGM = 8;

__host__ __device__ __forceinline__ int lds_byte(int r, int c) { const int st = (r >> 4) * 2 + (c >> 5), rr = r & 15, cc = c & 31, ob = rr * 64 + cc * 2; return st * 1024 + (ob ^ (((ob >> 9) & 1) << 5)); }
__host__ __device__ __forceinline__ void stage_rc(int b, int& R, int& C) { const int st = b / 1024, sb = b % 1024, swz = sb ^ (((sb >> 9) & 1) << 5); R = (st >> 1) * 16 + swz / 64; C = (st & 1) * 32 + (swz % 64) / 2; }
__host__ __device__ __forceinline__ int perm32(int rho) { const int n = rho >> 4, i = rho & 15; return 8 * (i >> 2) + 4 * n + (i & 3); }

struct Unit { int pm, pn; };
struct Gemm { const bf16_t* A; const bf16_t* Bt; int M, N, K; };

struct StaticOrder {
    int nM, nN, nwg, G, c, rev = 0;
    __host__ __device__ void init(int M, int N, int G_, int c_) { nM = M / BM; nN = N / BM; nwg = nM * nN; G = G_; c = c_; }
    __host__ __device__ bool next(int i, Unit& u) const {
        const int nr = (nwg - c + G - 1) / G; if (i >= nr) return false;
        const long L = (long)(rev ? nr - 1 - i : i) * G + c;
        int wgid = (int)L; { const int q = nwg / NXCD, r = nwg % NXCD, xcd = wgid % NXCD, off = wgid / NXCD; wgid = (xcd < r ? xcd * (q + 1) : r * (q + 1) + (xcd - r) * q) + off; }
        const int nig = WGM * nN, gid = wgid / nig, fm = gid * WGM, gsz = (nM - fm) < WGM ? (nM - fm) : WGM;
        u.pm = fm + ((wgid % nig) % gsz); u.pn = (wgid % nig) / gsz; return true;
    }
    __device__ __forceinline__ void a_ready(const Unit&) const {}
    __device__ __forceinline__ void done(const Unit&) const {}
};

__device__ __forceinline__ unsigned cvt_pk_bf16(float lo, float hi) { unsigned r; asm volatile("v_cvt_pk_bf16_f32 %0, %1, %2" : "=v"(r) : "v"(lo), "v"(hi)); return r; }
typedef float f32x2 __attribute__((ext_vector_type(2)));
typedef float f32x2 __attribute__((ext_vector_type(2)));
__device__ __forceinline__ u32x4 pack8(f32x4 v0, f32x4 v1) { u32x4 w; w.x = cvt_pk_bf16(v0[0], v0[1]); w.y = cvt_pk_bf16(v0[2], v0[3]); w.z = cvt_pk_bf16(v1[0], v1[1]); w.w = cvt_pk_bf16(v1[2], v1[3]); return w; }
__device__ __forceinline__ float sumsq4(f32x4 x) { return (x[0] * x[0] + x[1] * x[1]) + (x[2] * x[2] + x[3] * x[3]); }

struct EpiQKVU {
    static constexpr bool PERM = true, AFTER_DRAIN = false, HEADPERM = true;
    bf16_t *Q, *K, *V, *U; const PG8_LAS float* nwl;
    __device__ __forceinline__ void operator()(const f32x4 (&acc)[2][2][4][2], const Unit& u, int wr, int wc, int fr, int fq) const {
        const int sel = u.pn >> 1;
        bf16_t* base = sel == 0 ? Q : (sel == 1 ? K : (sel == 2 ? V : U));
        const int colb = (u.pn & 1) * 256 + wc * 64 + 8 * fq;
        const int row0 = u.pm * BM + wr * 64 + fr;
        if (sel < 2) {
            const PG8_LAS float* w = nwl + sel * 64;
            f32x4 wv[2][2];
#pragma unroll
            for (int bj = 0; bj < 2; ++bj)
#pragma unroll
                for (int n = 0; n < 2; ++n) wv[bj][n] = *(const PG8_LAS f32x4*)(w + 32 * bj + 8 * fq + 4 * n);
#pragma unroll
            for (int ai = 0; ai < 2; ++ai)
#pragma unroll
                for (int m = 0; m < 4; ++m) {
                    float ss = (sumsq4(acc[ai][0][m][0]) + sumsq4(acc[ai][0][m][1])) + (sumsq4(acc[ai][1][m][0]) + sumsq4(acc[ai][1][m][1]));
                    ss += __shfl_xor(ss, 16); ss += __shfl_xor(ss, 32);
                    const float rs = 1.0f / sqrtf(ss * (1.0f / 64.0f) + 1e-6f);
                    bf16_t* rowp = base + (size_t)(row0 + ai * HALF + m * 16) * 512 + colb;
#pragma unroll
                    for (int bj = 0; bj < 2; ++bj) { const u32x4 pv = pack8(acc[ai][bj][m][0] * rs * wv[bj][0], acc[ai][bj][m][1] * rs * wv[bj][1]);
                        if (sel == 0) __builtin_nontemporal_store(pv, (u32x4*)(rowp + 32 * bj)); else *(u32x4*)(rowp + 32 * bj) = pv; }
                }
        } else {
#pragma unroll
            for (int ai = 0; ai < 2; ++ai)
#pragma unroll
                for (int m = 0; m < 4; ++m) { bf16_t* rowp = base + (size_t)(row0 + ai * HALF + m * 16) * 512 + colb;
#pragma unroll
                    for (int bj = 0; bj < 2; ++bj) { const u32x4 pv = pack8(acc[ai][bj][m][0], acc[ai][bj][m][1]);
                        if (sel == 3) __builtin_nontemporal_store(pv, (u32x4*)(rowp + 32 * bj)); else *(u32x4*)(rowp + 32 * bj) = pv; } }
        }
    }
};

struct EpiRes1 {
    static constexpr bool PERM = true, AFTER_DRAIN = false, HEADPERM = false;
    const float* x; float* out; bf16_t* xn2; float* ssq;
    __device__ __forceinline__ void operator()(const f32x4 (&acc)[2][2][4][2], const Unit& u, int wr, int wc, int fr, int fq) const {
        const int row0 = u.pm * BM + wr * 64 + fr, col0 = u.pn * BM + wc * 32 + 8 * fq;
#pragma unroll
        for (int ai = 0; ai < 2; ++ai)
#pragma unroll
            for (int m = 0; m < 4; ++m) { const int row = row0 + ai * HALF + m * 16; const size_t off = (size_t)row * 1024 + col0; float ss = 0.f;
#pragma unroll
                for (int bj = 0; bj < 2; ++bj) {
                    const f32x4 h0 = *(const f32x4*)(x + off + bj * HALF) + acc[ai][bj][m][0], h1 = *(const f32x4*)(x + off + bj * HALF + 4) + acc[ai][bj][m][1];
                    *(u32x4*)(xn2 + off + bj * HALF) = pack8(h0, h1);
                    ss += sumsq4(h0) + sumsq4(h1); }
                ss += __shfl_xor(ss, 16); ss += __shfl_xor(ss, 32);
                if (fq == 0) ssq[(size_t)row * 16 + u.pn * 4 + wc] = ss; }
    }
};

struct EpiSwiGLU {
    static constexpr bool PERM = true, AFTER_DRAIN = false, HEADPERM = false;
    bf16_t* H; const PG8_LAS float* rstd_lds; int pmA; const float* ssq;
    __device__ __forceinline__ void operator()(const f32x4 (&acc)[2][2][4][2], const Unit& u, int wr, int wc, int fr, int fq) const {
        const int row0 = u.pm * BM + wr * 64 + fr, col0 = u.pn * HALF + wc * 32 + 8 * fq;
        const PG8_LAS float* rl = rstd_lds + (u.pm == pmA ? 0 : 256) + wr * 64 + fr;
#pragma unroll
        for (int ai = 0; ai < 2; ++ai)
#pragma unroll
            for (int m = 0; m < 4; ++m) { const int row = row0 + ai * HALF + m * 16;
                float rs;
                if (ssq) { const f32x4* sp = (const f32x4*)(ssq + (size_t)row * 16); const f32x4 s0 = sp[0], s1 = sp[1], s2 = sp[2], s3 = sp[3];
                    rs = 1.0f / sqrtf(((((s0[0] + s0[1]) + (s0[2] + s0[3])) + ((s1[0] + s1[1]) + (s1[2] + s1[3]))) + (((s2[0] + s2[1]) + (s2[2] + s2[3])) + ((s3[0] + s3[1]) + (s3[2] + s3[3])))) * (1.0f / 1024.0f) + 1e-6f); }
                else rs = rl[ai * HALF + m * 16];
                const float rsn = rs * -1.4426950408889634f, rs2 = rs * rs;
                f32x4 o[2];
#pragma unroll
                for (int n = 0; n < 2; ++n) { const f32x4 ag = acc[ai][0][m][n], t = ag * rsn;
                    f32x4 d = {__builtin_amdgcn_exp2f(t[0]), __builtin_amdgcn_exp2f(t[1]), __builtin_amdgcn_exp2f(t[2]), __builtin_amdgcn_exp2f(t[3])}; d = d + 1.0f;
                    const f32x4 r = {__builtin_amdgcn_rcpf(d[0]), __builtin_amdgcn_rcpf(d[1]), __builtin_amdgcn_rcpf(d[2]), __builtin_amdgcn_rcpf(d[3])};
                    o[n] = (ag * acc[ai][1][m][n]) * (r * rs2); }
                *(u32x4*)(H + (size_t)row * 2816 + col0) = pack8(o[0], o[1]); }
    }
};

struct EpiRes2 {
    static constexpr bool PERM = true, AFTER_DRAIN = false, HEADPERM = false;
    float* out; const bf16_t* xn2;
    __device__ __forceinline__ void operator()(const f32x4 (&acc)[2][2][4][2], const Unit& u, int wr, int wc, int fr, int fq) const {
        const int row0 = u.pm * BM + wr * 64 + fr, col0 = u.pn * BM + wc * 32 + 8 * fq;
#pragma unroll
        for (int ai = 0; ai < 2; ++ai)
#pragma unroll
            for (int m = 0; m < 4; ++m) { const size_t off = (size_t)(row0 + ai * HALF + m * 16) * 1024 + col0;
#pragma unroll
                for (int bj = 0; bj < 2; ++bj) { const u32x4 h = __builtin_nontemporal_load((const u32x4*)(xn2 + off + bj * HALF));
                    const f32x4 h0 = {__uint_as_float(h.x << 16), __uint_as_float(h.x & 0xffff0000u), __uint_as_float(h.y << 16), __uint_as_float(h.y & 0xffff0000u)};
                    const f32x4 h1 = {__uint_as_float(h.z << 16), __uint_as_float(h.z & 0xffff0000u), __uint_as_float(h.w << 16), __uint_as_float(h.w & 0xffff0000u)};
                    __builtin_nontemporal_store(h0 + acc[ai][bj][m][0], (f32x4*)(out + off + bj * HALF)); __builtin_nontemporal_store(h1 + acc[ai][bj][m][1], (f32x4*)(out + off + bj * HALF + 4)); } }
    }
};
template <class Epi, class Sched, bool ALIGN_EPI = false, bool SP2 = false, bool LIGHT = false>
__device__ __forceinline__ void gemm_phase(PG8_LAS unsigned char* lds, const Gemm g, const Sched& S, const Epi& E) {
    int tid_ = threadIdx.x; asm volatile("" : "+v"(tid_));
    const int tid = tid_, wid = __builtin_amdgcn_readfirstlane(tid >> 6), lane = tid & 63, wr = wid >> 2, wc = wid & 3, fr = lane & 15, fq = lane >> 4;
    const int K = g.K, nt = K / BK;
    unsigned voffA[2], voffB[2];
#pragma unroll
    for (int i = 0; i < 2; ++i) { int R, C; stage_rc(tid * 16 + i * 8192, R, C); const int Rb = Epi::HEADPERM ? (64 * (R >> 5) + perm32(R & 31)) : (Epi::PERM ? ((R & ~31) + perm32(R & 31)) : R);
        voffA[i] = (unsigned)(R * K + C) * 2u; voffB[i] = (unsigned)(Rb * K + C) * 2u; }
    const size_t kstep = (size_t)(BK * 2);
    const size_t hstep = (size_t)HALF * K * 2;
    const size_t hstepB = Epi::HEADPERM ? (size_t)32 * K * 2 : hstep;
    const size_t tstep = 2 * hstep;
    const unsigned ldsw = (unsigned)wid * 1024u;
    const int aoff = lds_byte(wr * 64 + fr, fq * 8), boff = lds_byte(wc * 32 + fr, fq * 8);
#define PG8_SA(b, h) (((b) * 2 + (h)) * HTB)
#define PG8_SB(b, h) ((4 + (b) * 2 + (h)) * HTB)
#define PG8_STAGE(bufoff, gbase, voff) do { _Pragma("unroll") for (int _i = 0; _i < 2; ++_i) \
        __builtin_amdgcn_global_load_lds((const unsigned*)((const char*)(gbase) + (voff)[_i]), (PG8_LAS unsigned*)(lds + (bufoff) + ldsw + _i * 8192), 16, 0, 0); } while (0)
#define PG8_LDA(dst, b, h) do { _Pragma("unroll") for (int m = 0; m < 4; ++m) _Pragma("unroll") for (int k = 0; k < 2; ++k) dst[m][k] = *(const PG8_LAS bf16x8*)(lds + PG8_SA(b, h) + aoff + m * 2048 + k * 1024); } while (0)
#define PG8_LDB(dst, b, h) do { _Pragma("unroll") for (int n = 0; n < 2; ++n) _Pragma("unroll") for (int k = 0; k < 2; ++k) dst[n][k] = *(const PG8_LAS bf16x8*)(lds + PG8_SB(b, h) + boff + n * 2048 + k * 1024); } while (0)
#define PG8_MMA(ai, bj, At, Bt) do { if constexpr (!LIGHT) { __builtin_amdgcn_s_setprio(1); _Pragma("unroll") for (int m = 0; m < 4; ++m) _Pragma("unroll") for (int n = 0; n < 2; ++n) _Pragma("unroll") for (int k = 0; k < 2; ++k) \
        acc[ai][bj][m][n] = __builtin_amdgcn_mfma_f32_16x16x32_bf16(Bt[n][k], At[m][k], acc[ai][bj][m][n], 0, 0, 0); __builtin_amdgcn_s_setprio(0); } \
    else if ((ai) == 0 && wr == 0) { _Pragma("unroll") for (int n = 0; n < 2; ++n) _Pragma("unroll") for (int k = 0; k < 2; ++k) acc[ai][bj][0][n] = __builtin_amdgcn_mfma_f32_16x16x32_bf16(Bt[n][k], At[0][k], acc[ai][bj][0][n], 0, 0, 0); } } while (0)
#define PG8_WAIT_V(n) asm volatile("s_waitcnt vmcnt(" #n ")" ::: "memory")
#define PG8_WAIT_L(n) asm volatile("s_waitcnt lgkmcnt(" #n ")" ::: "memory")
#define PG8_BAR __builtin_amdgcn_s_barrier()
#define PG8_SCHED __builtin_amdgcn_sched_barrier(0)
    Unit cur, nxt; int ui = 0;
    if (!S.next(0, cur)) return;
    f32x4 acc[2][2][4][2];
#pragma unroll
    for (int a = 0; a < 2; ++a)
#pragma unroll
        for (int b = 0; b < 2; ++b)
#pragma unroll
            for (int m = 0; m < 4; ++m)
#pragma unroll
                for (int n = 0; n < 2; ++n) acc[a][b][m][n] = (f32x4){0.f, 0.f, 0.f, 0.f};
    bf16x8 At[4][2], B0[2][2], B1[2][2];
    const char* cA = (const char*)g.A + (size_t)cur.pm * tstep; const char* cB = (const char*)g.Bt + (size_t)cur.pn * tstep;
    S.a_ready(cur);
    if constexpr (SP2) {
        PG8_STAGE(PG8_SB(0, 0), cB, voffB); PG8_STAGE(PG8_SB(0, 1), cB + hstepB, voffB); PG8_STAGE(PG8_SA(0, 0), cA, voffA); PG8_STAGE(PG8_SA(0, 1), cA + hstep, voffA);
        if (wr == 1) PG8_BAR;
        PG8_WAIT_V(2); PG8_BAR;
        PG8_STAGE(PG8_SB(1, 0), cB + kstep, voffB); PG8_STAGE(PG8_SA(1, 0), cA + kstep, voffA); PG8_STAGE(PG8_SB(1, 1), cB + hstepB + kstep, voffB);
        PG8_WAIT_V(6); PG8_BAR;
    } else {
        PG8_STAGE(PG8_SB(0, 0), cB, voffB); PG8_STAGE(PG8_SA(0, 0), cA, voffA); PG8_STAGE(PG8_SB(0, 1), cB + hstepB, voffB); PG8_STAGE(PG8_SA(0, 1), cA + hstep, voffA);
        if (wr == 1) PG8_BAR;
        PG8_WAIT_V(4); PG8_BAR;
        PG8_STAGE(PG8_SB(1, 0), cB + kstep, voffB); PG8_STAGE(PG8_SA(1, 0), cA + kstep, voffA); PG8_STAGE(PG8_SB(1, 1), cB + hstepB + kstep, voffB);
        PG8_WAIT_V(6); PG8_BAR;
    }
    for (;;) {
        const bool has_next = S.next(ui + 1, nxt);
        const char* nA = has_next ? (const char*)g.A + (size_t)nxt.pm * tstep : cA; const char* nB = has_next ? (const char*)g.Bt + (size_t)nxt.pn * tstep : cB;
        for (int t = 0; t < nt; t += 2) {
            const bool last = (t == nt - 2);
            const char* a1 = cA + (size_t)(t + 1) * kstep;
            const char* a2 = last ? nA : cA + (size_t)(t + 2) * kstep; const char* b2 = last ? nB : cB + (size_t)(t + 2) * kstep;
            const char* a3 = a2 + kstep; const char* b3 = b2 + kstep;
            if (last && has_next) S.a_ready(nxt);
            if constexpr (SP2) {
            PG8_LDB(B0, 0, 0); PG8_LDB(B1, 0, 1); PG8_SCHED; PG8_LDA(At, 0, 0); PG8_STAGE(PG8_SA(1, 1), a1 + hstep, voffA);
            PG8_WAIT_V(8); PG8_WAIT_L(0); PG8_BAR; PG8_MMA(0, 0, At, B0); PG8_MMA(0, 1, At, B1); PG8_BAR; PG8_SCHED;
            PG8_LDA(At, 0, 1); PG8_STAGE(PG8_SB(0, 0), b2, voffB); PG8_STAGE(PG8_SB(0, 1), b2 + hstepB, voffB); PG8_STAGE(PG8_SA(0, 0), a2, voffA);
            PG8_WAIT_V(8); PG8_WAIT_L(0); PG8_BAR; PG8_MMA(1, 0, At, B0); PG8_MMA(1, 1, At, B1); PG8_BAR; PG8_SCHED;
            PG8_LDB(B0, 1, 0); PG8_LDB(B1, 1, 1); PG8_SCHED; PG8_LDA(At, 1, 0); PG8_STAGE(PG8_SA(0, 1), a2 + hstep, voffA);
            PG8_WAIT_V(8); PG8_WAIT_L(0); PG8_BAR; PG8_MMA(0, 0, At, B0); PG8_MMA(0, 1, At, B1); PG8_BAR; PG8_SCHED;
            PG8_LDA(At, 1, 1); PG8_STAGE(PG8_SB(1, 0), b3, voffB); PG8_STAGE(PG8_SB(1, 1), b3 + hstepB, voffB); PG8_STAGE(PG8_SA(1, 0), a3, voffA);
            PG8_WAIT_V(8); PG8_WAIT_L(0); PG8_BAR; PG8_MMA(1, 0, At, B0); PG8_MMA(1, 1, At, B1); PG8_BAR; PG8_SCHED;
            } else {
            PG8_LDB(B0, 0, 0); PG8_SCHED; PG8_LDA(At, 0, 0); PG8_STAGE(PG8_SA(1, 1), a1 + hstep, voffA);
            PG8_WAIT_L(8); PG8_BAR; PG8_WAIT_L(0); PG8_MMA(0, 0, At, B0); PG8_BAR; PG8_SCHED;
            PG8_LDB(B1, 0, 1); PG8_STAGE(PG8_SB(0, 0), b2, voffB);
            PG8_BAR; PG8_WAIT_L(0); PG8_MMA(0, 1, At, B1); PG8_BAR;
            PG8_LDA(At, 0, 1); PG8_STAGE(PG8_SA(0, 0), a2, voffA);
            PG8_BAR; PG8_WAIT_L(0); PG8_MMA(1, 0, At, B0); PG8_BAR; PG8_SCHED;
            PG8_STAGE(PG8_SB(0, 1), b2 + hstepB, voffB);
            PG8_WAIT_V(6); PG8_BAR; PG8_MMA(1, 1, At, B1); PG8_BAR;
            PG8_LDB(B0, 1, 0); PG8_SCHED; PG8_LDA(At, 1, 0); PG8_STAGE(PG8_SA(0, 1), a2 + hstep, voffA);
            PG8_WAIT_L(8); PG8_BAR; PG8_WAIT_L(0); PG8_MMA(0, 0, At, B0); PG8_BAR; PG8_SCHED;
            PG8_LDB(B1, 1, 1); PG8_STAGE(PG8_SB(1, 0), b3, voffB);
            PG8_BAR; PG8_WAIT_L(0); PG8_MMA(0, 1, At, B1); PG8_BAR;
            PG8_LDA(At, 1, 1); PG8_STAGE(PG8_SA(1, 0), a3, voffA);
            PG8_BAR; PG8_WAIT_L(0); PG8_MMA(1, 0, At, B0); PG8_BAR; PG8_SCHED;
            PG8_STAGE(PG8_SB(1, 1), b3 + hstepB, voffB);
            PG8_WAIT_V(6); PG8_BAR; PG8_MMA(1, 1, At, B1); PG8_BAR;
            }
        }
        if constexpr (ALIGN_EPI) { if (wr == 0) PG8_BAR; }
        if constexpr (!Epi::AFTER_DRAIN) { E(acc, cur, wr, wc, fr, fq); S.done(cur); }
        if (!has_next) break;
#pragma unroll
        for (int a = 0; a < 2; ++a)
#pragma unroll
            for (int b = 0; b < 2; ++b)
#pragma unroll
                for (int m = 0; m < 4; ++m)
#pragma unroll
                    for (int n = 0; n < 2; ++n) acc[a][b][m][n] = (f32x4){0.f, 0.f, 0.f, 0.f};
        cur = nxt; cA = nA; cB = nB; ++ui;
        if constexpr (ALIGN_EPI) { if (wr == 1) PG8_BAR; }
    }
    PG8_WAIT_V(0);
    if constexpr (!ALIGN_EPI) { if (wr == 0) PG8_BAR; }
    PG8_BAR;
    if constexpr (Epi::AFTER_DRAIN) { E.fused(acc, cur, wr, wc, fr, fq, lds, wid, lane); S.done(cur); }
#undef PG8_SA
#undef PG8_SB
#undef PG8_STAGE
#undef PG8_LDA
#undef PG8_LDB
#undef PG8_MMA
#undef PG8_WAIT_V
#undef PG8_WAIT_L
#undef PG8_BAR
#undef PG8_SCHED
}
}

#include <hip/hip_bf16.h>
#include <cmath>
namespace attn_body {
using bf16=__hip_bfloat16;
using bf16x8=__attribute__((ext_vector_type(8)))short;
using s16x4=__attribute__((ext_vector_type(4)))short;
using f32x16=__attribute__((ext_vector_type(16)))float;
using u32x4=__attribute__((ext_vector_type(4)))unsigned;
constexpr int BATCH=4,NHEAD=8,SEQ=8192,D=64,DM=NHEAD*D,OPITCH=1024,MROW=BATCH*SEQ;
constexpr int NW=8,QBLK=32,QB=QBLK*NW,KVBLK=64,NQB=SEQ/QB;
constexpr int ATTN_PITCH=DM, ATTN_UNIT_ROWS=QB;
__device__ __forceinline__ int crow(int r,int hi){return (r&3)+8*(r>>2)+4*hi;}
#define SBAR() __builtin_amdgcn_sched_barrier(0)
__device__ __forceinline__ void cmask(f32x16&p0,f32x16&p1,int jb,int qrel,int hi){
  const float NEG=-INFINITY; int kb=64*jb+4*hi;
  #pragma unroll
  for(int r=0;r<16;++r){int kv=kb+(r&3)+8*(r>>2); if(kv>qrel)p0[r]=NEG; if(kv+32>qrel)p1[r]=NEG;}
}

constexpr int NSLOT=3, SLOTB=8192;
constexpr int LDS_K=0, LDS_V=NSLOT*SLOTB, LDS_WS=2*NSLOT*SLOTB, LDS_OST=LDS_WS+NW*64*4, LDS_BIAS=LDS_OST+NW*4096,LDS_BYTES=LDS_BIAS+132*64*4;
constexpr float C2=0.125f*1.4426950408889634f;
__device__ __forceinline__ void glds16(const void*gsrc,unsigned lds_dst){unsigned keep;
  asm volatile("s_mov_b32 %0, m0\n\ts_mov_b32 m0, %2\n\ts_nop 0\n\tglobal_load_lds_dwordx4 %1, off\n\ts_mov_b32 m0, %0":"=&s"(keep):"v"(gsrc),"s"(lds_dst):"memory");}
__device__ __forceinline__ float max3f(float a,float b,float c){float r;asm("v_max3_f32 %0, %1, %2, %3":"=v"(r):"v"(a),"v"(b),"v"(c));return r;}
__device__ __forceinline__ float max2f(float a,float b){float r;asm("v_max_f32_e32 %0, %1, %2":"=v"(r):"v"(a),"v"(b));return r;}
__device__ __forceinline__ float fadd_s(float a,float b){float r;asm("v_add_f32_e32 %0, %1, %2":"=v"(r):"v"(a),"v"(b));return r;}
__device__ __forceinline__ float fsub_s(float a,float b){float r;asm("v_sub_f32_e32 %0, %1, %2":"=v"(r):"v"(a),"v"(b));return r;}
typedef float f32x4_t __attribute__((ext_vector_type(4))); typedef float f32x2_t __attribute__((ext_vector_type(2))); typedef __bf16 bf16x2_t __attribute__((ext_vector_type(2)));
__device__ __forceinline__ unsigned cvtpk_s(float lo,float hi){f32x2_t v={lo,hi};bf16x2_t b=__builtin_convertvector(v,bf16x2_t);return __builtin_bit_cast(unsigned,b);}
#define WAIT_BAR(N) asm volatile("s_waitcnt vmcnt(" #N ") lgkmcnt(0)\n\ts_barrier":::"memory")

__device__ __forceinline__ void qkt(f32x16&p0,f32x16&p1,const char*Kslot,const bf16x8*qr,int r32,int hi){
  const char*kb=Kslot+hi*1024+r32*16;
  #pragma unroll
  for(int d0=0;d0<4;++d0){
    const bf16x8 b0=*reinterpret_cast<const bf16x8*>(kb+d0*2048);
    const bf16x8 b1=*reinterpret_cast<const bf16x8*>(kb+d0*2048+512);
    {p0=__builtin_amdgcn_mfma_f32_32x32x16_bf16(b0,qr[d0],p0,0,0,0);p1=__builtin_amdgcn_mfma_f32_32x32x16_bf16(b1,qr[d0],p1,0,0,0);}}
}
typedef __attribute__((address_space(3))) const char* lds_cptr;
typedef short v4i16_t __attribute__((ext_vector_type(4)));
__device__ __forceinline__ void kload8(bf16x8*kf,lds_cptr kp){
  kf[0]=*(const __attribute__((address_space(3))) bf16x8*)(kp);      kf[1]=*(const __attribute__((address_space(3))) bf16x8*)(kp+512);
  kf[2]=*(const __attribute__((address_space(3))) bf16x8*)(kp+2048); kf[3]=*(const __attribute__((address_space(3))) bf16x8*)(kp+2560);
  kf[4]=*(const __attribute__((address_space(3))) bf16x8*)(kp+4096); kf[5]=*(const __attribute__((address_space(3))) bf16x8*)(kp+4608);
  kf[6]=*(const __attribute__((address_space(3))) bf16x8*)(kp+6144); kf[7]=*(const __attribute__((address_space(3))) bf16x8*)(kp+6656);
}
__device__ __forceinline__ void kload2(bf16x8*kf,lds_cptr kp,int j){ kf[2*j]=*(const __attribute__((address_space(3))) bf16x8*)(kp+j*2048); kf[2*j+1]=*(const __attribute__((address_space(3))) bf16x8*)(kp+j*2048+512); }
__device__ __forceinline__ s16x4 vtr(lds_cptr p){ return __builtin_bit_cast(s16x4,__builtin_amdgcn_ds_read_tr16_b64_v4i16((__attribute__((address_space(3))) v4i16_t*)p)); }
__device__ __forceinline__ float rowmax(const f32x16&p0,const f32x16&p1){
  float a=max3f(p0[0],p0[1],p1[0]),b=max3f(p0[2],p0[3],p1[1]);a=max3f(a,p1[2],p1[3]);
  #pragma unroll
  for(int r=4;r<16;r+=4){a=max3f(a,p0[r],p0[r+1]);b=max3f(b,p0[r+2],p0[r+3]);a=max3f(a,p1[r],p1[r+1]);b=max3f(b,p1[r+2],p1[r+3]);}
  const float m=max2f(a,b);
  auto rr=__builtin_amdgcn_permlane32_swap(__float_as_uint(m),__float_as_uint(m),false,false);
  return max2f(__uint_as_float(rr[0]),__uint_as_float(rr[1]));
}
__device__ __forceinline__ void pv(f32x16*o,int vb,bf16x8 pa0,bf16x8 pa1,bf16x8 pa2,bf16x8 pa3){
  #pragma unroll
  for(int d0=0;d0<2;++d0){s16x4 lo[4],hi[4];
    #pragma unroll
    for(int ks=0;ks<4;++ks){
      asm volatile("ds_read_b64_tr_b16 %0,%1 offset:%c2":"=&v"(lo[ks]):"v"(vb),"i"(d0*4096+ks*1024):"memory");
      asm volatile("ds_read_b64_tr_b16 %0,%1 offset:%c2":"=&v"(hi[ks]):"v"(vb),"i"(d0*4096+ks*1024+512):"memory");}
    asm volatile("s_waitcnt lgkmcnt(0)":::"memory");SBAR();
    #define PK(k) (bf16x8){lo[k][0],lo[k][1],lo[k][2],lo[k][3],hi[k][0],hi[k][1],hi[k][2],hi[k][3]}
    o[d0]=__builtin_amdgcn_mfma_f32_32x32x16_bf16(pa0,PK(0),o[d0],0,0,0);
    o[d0]=__builtin_amdgcn_mfma_f32_32x32x16_bf16(pa1,PK(1),o[d0],0,0,0);
    o[d0]=__builtin_amdgcn_mfma_f32_32x32x16_bf16(pa2,PK(2),o[d0],0,0,0);
    o[d0]=__builtin_amdgcn_mfma_f32_32x32x16_bf16(pa3,PK(3),o[d0],0,0,0);
    #undef PK
  }
}

#ifndef ATTN_STORE16
#define ATTN_STORE16(p,v) (*(u32x4*)(p)=(v))
#endif
template<int THRL> __device__ __forceinline__ void attn_unit(int b,int h,int qb,int lo,const float*__restrict__ vb,const bf16*Q,const bf16*__restrict__ K,const bf16*__restrict__ V,bf16*O,char*shm){
  int tid_=threadIdx.x; asm volatile("":"+v"(tid_)); const int tid=tid_,lane=tid&63,r32=lane&31,hi=lane>>5; const int wid=__builtin_amdgcn_readfirstlane(tid>>6);
  const long rowbase=(long)b*SEQ; const int q0=qb*QB;
  #define TOFF(t) ((long)(((lo)+(t))<2?(long)MROW:rowbase+64L*((lo)+(t)-2))*DM)
  const bf16*Qw=Q+(rowbase+q0+wid*QBLK)*DM+h*D;
  const bf16*Kh=K+h*D,*Vh=V+h*D;
  const unsigned lds0=(unsigned)(uintptr_t)shm;
  float*wsf=(float*)(shm+LDS_WS)+wid*64;
  const bf16*ksrc=Kh+(long)lane*DM+wid*8;
  const bf16*vsrc=Vh+(long)(16*(wid&3)+(lane>>2))*DM+(wid>>2)*32+(lane&3)*8;
  const unsigned kdst=lds0+LDS_K+wid*1024, vdst=lds0+LDS_V+wid*1024;
  #define DMA_K(t,slot) glds16(ksrc+TOFF(t),(unsigned)__builtin_amdgcn_readfirstlane(kdst+(slot)))
  #define DMA_V(t,slot) glds16(vsrc+TOFF(t),(unsigned)__builtin_amdgcn_readfirstlane(vdst+(slot)))
  const int vb0=(int)(lds0+LDS_V)+((lane>>4)&1)*32+(lane&3)*8+(4*hi+((lane&15)>>2))*64;
  const char*Kbase=shm+LDS_K; bf16x8 kf[8];
  const lds_cptr shm3=(lds_cptr)shm; const lds_cptr kp0=shm3+LDS_K+hi*1024+r32*16; const lds_cptr vp0=shm3+LDS_V+((lane>>4)&1)*32+(lane&3)*8+(4*hi+((lane&15)>>2))*64;
  const int NT=4*qb+6-lo;
  for(int p_=wid;p_<((NT+3)>>2);p_+=NW) glds16(vb+(long)lo*64+p_*256+lane*4,(unsigned)__builtin_amdgcn_readfirstlane(lds0+LDS_BIAS+p_*1024));
  DMA_K(0,0);DMA_V(0,0);DMA_K(1,SLOTB);
  bf16x8 qr[4];
  #pragma unroll
  for(int d0=0;d0<4;++d0)qr[d0]=__builtin_nontemporal_load(reinterpret_cast<const bf16x8*>(&Qw[(long)r32*DM+d0*16+hi*8]));
  const lds_cptr bp0=(lds_cptr)shm+LDS_BIAS+hi*16;
  #define BLD(G,P0,P1,t) do{ if(G){ const lds_cptr bp_=bp0+(t)*256; _Pragma("unroll") for(int j_=0;j_<4;++j_){ \
      const f32x4_t b0_=*(const __attribute__((address_space(3))) f32x4_t*)(bp_+j_*32), b1_=*(const __attribute__((address_space(3))) f32x4_t*)(bp_+128+j_*32); \
      _Pragma("unroll") for(int i_=0;i_<4;++i_){ P0[4*j_+i_]=b0_[i_]; P1[4*j_+i_]=b1_[i_]; } } } }while(0)
  #define BSUB(G,P0,P1) do{ if(G){ _Pragma("unroll") for(int r_=0;r_<16;++r_){ P0[r_]-=mhat; P1[r_]-=mhat; } } }while(0)
  float mhat=0.f,l_reg=0.f;f32x16 o[2];o[0]=f32x16{};o[1]=f32x16{};
  const int qrel=wid*QBLK+r32;
  #define CMASK(P0,P1,t) do{int jb_=(t)-(NT-4); if(jb_>=0)cmask(P0,P1,jb_,qrel,hi);}while(0)
  bool resc=false;
  #define START(P0,P1) do{ const float rm=__builtin_fmaxf(rowmax(P0,P1),*(const __attribute__((address_space(3))) float*)((lds_cptr)shm+LDS_BIAS+((NT-4)*64+qrel)*4)); resc=false; \
    { const float dl=rm; mhat=fadd_s(mhat,dl); \
      _Pragma("unroll") for(int r=0;r<16;++r){P0[r]=fsub_s(P0[r],dl);P1[r]=fsub_s(P1[r],dl);} \
      } \
    _Pragma("unroll") for(int r=0;r<16;++r)P0[r]=__builtin_amdgcn_exp2f(P0[r]); }while(0)
  #define RESC() do{ if(resc){ asm volatile("s_waitcnt lgkmcnt(0)":::"memory"); \
      _Pragma("unroll") for(int d_=0;d_<2;++d_) _Pragma("unroll") for(int r=0;r<16;++r)o[d_][r]*=wsf[crow(r,hi)]; } }while(0)
  f32x16 pA0,pA1,pB0,pB1;
  int sl_prev=0,sl_cur=0,sl_next=SLOTB;
  #define ROT() do{sl_prev=sl_cur;sl_cur=sl_next;sl_next=(sl_next==(NSLOT-1)*SLOTB)?0:sl_next+SLOTB;}while(0)
  DMA_K(2,2*SLOTB);
  WAIT_BAR(3);
  BLD(true,pA0,pA1,0);qkt(pA0,pA1,Kbase,qr,r32,hi);asm volatile("s_nop 15\n\ts_nop 7":"+v"(pA0),"+v"(pA1));CMASK(pA0,pA1,0);
  START(pA0,pA1);
  _Pragma("unroll") for(int r=0;r<16;++r)pA1[r]=__builtin_amdgcn_exp2f(pA1[r]);
  BLD(true,pB0,pB1,1); BSUB(true,pB0,pB1);
  WAIT_BAR(0);
  DMA_K(3,0);DMA_V(1,SLOTB);
  ROT();
  kload8(kf,kp0+sl_cur);
  WAIT_BAR(2);
  s16x4 vlo[8],vhi[8]; u32x4 pw0,pw1,pw2,pw3;
  #define PKW(P,B) cvtpk_s(P[B],P[B+1])
  #define PAF(k) __builtin_bit_cast(bf16x8,pw##k)
  #define VFR(i) (bf16x8){vlo[i][0],vlo[i][1],vlo[i][2],vlo[i][3],vhi[i][0],vhi[i][1],vhi[i][2],vhi[i][3]}
  #define PIN(x) asm volatile("":"+v"(x))
  #define MX3(a,b,c) __builtin_fmaxf(__builtin_fmaxf((a),(b)),(c))
  #define GAPA(MF,A0,A1,A2,A3,W0,W1,PW) do{ MF; sacc+=A0; sacc+=A1; sacc+=A2; sacc+=A3; PIN(sacc); W0; W1; PIN(PW); SBAR(); }while(0)
  #define EX(v) __builtin_amdgcn_exp2f(v)
  #define GAPB(MF,X,B) do{ MF; X[B]=EX(X[B]); X[B+1]=EX(X[B+1]); X[B+2]=EX(X[B+2]); X[B+3]=EX(X[B+3]); PIN(X); SBAR(); }while(0)
  #define VRD(i) do{ vlo[i]=vtr(vp_+(((i)>>2)*4096+((i)&3)*1024)); vhi[i]=vtr(vp_+(((i)>>2)*4096+((i)&3)*1024+512)); }while(0)
  #define KRD(G,j) do{ if(G){ kload2(kf,kp0+sl_next,j); SBAR(); } }while(0)
  #define STEP(C0,C1,P0,P1,t,GK,GV,GL) do{ SBAR(); \
    const lds_cptr vp_=vp0+sl_prev; \
    VRD(0); SBAR(); float sacc=(P0[0]+P0[1]); \
    GAPA(C0=__builtin_amdgcn_mfma_f32_32x32x16_bf16(kf[0],qr[0],C0,0,0,0), P0[2],P0[3],P0[4],P0[5],     pw0[0]=PKW(P0,0), pw0[1]=PKW(P0,2), pw0); \
    VRD(4); SBAR(); GAPA(C1=__builtin_amdgcn_mfma_f32_32x32x16_bf16(kf[1],qr[0],C1,0,0,0), P0[6],P0[7],P0[8],P0[9],     pw0[2]=PKW(P0,4), pw0[3]=PKW(P0,6), pw0); \
    VRD(1); SBAR(); GAPA(C0=__builtin_amdgcn_mfma_f32_32x32x16_bf16(kf[2],qr[1],C0,0,0,0),   P0[10],P0[11],P0[12],P0[13], pw1[0]=PKW(P0,8), pw1[1]=PKW(P0,10), pw1); \
    VRD(5); SBAR(); GAPA(C1=__builtin_amdgcn_mfma_f32_32x32x16_bf16(kf[3],qr[1],C1,0,0,0),   P0[14],P0[15],P1[0],P1[1],   pw1[2]=PKW(P0,12),pw1[3]=PKW(P0,14), pw1); \
    VRD(2); SBAR(); GAPA(C0=__builtin_amdgcn_mfma_f32_32x32x16_bf16(kf[4],qr[2],C0,0,0,0),   P1[2],P1[3],P1[4],P1[5],     pw2[0]=PKW(P1,0), pw2[1]=PKW(P1,2), pw2); \
    VRD(6); SBAR(); GAPA(C1=__builtin_amdgcn_mfma_f32_32x32x16_bf16(kf[5],qr[2],C1,0,0,0),   P1[6],P1[7],P1[8],P1[9],     pw2[2]=PKW(P1,4), pw2[3]=PKW(P1,6), pw2); \
    VRD(3); SBAR(); GAPA(C0=__builtin_amdgcn_mfma_f32_32x32x16_bf16(kf[6],qr[3],C0,0,0,0),   P1[10],P1[11],P1[12],P1[13], pw3[0]=PKW(P1,8), pw3[1]=PKW(P1,10), pw3); \
    VRD(7); SBAR(); GAPA(C1=__builtin_amdgcn_mfma_f32_32x32x16_bf16(kf[7],qr[3],C1,0,0,0),   P1[14],P1[15],0.f,0.f,       pw3[2]=PKW(P1,12),pw3[3]=PKW(P1,14), pw3); \
    l_reg+=sacc; \
    if(GK){DMA_K((t)+3,sl_cur);} if(GV){DMA_V((t)+1,sl_next);} \
    CMASK(C0,C1,t); \
    { float a=MX3(C0[0],C0[1],C1[0]),b=MX3(C0[2],C0[3],C1[1]); a=MX3(a,C1[2],C1[3]); \
      _Pragma("unroll") for(int r=4;r<16;r+=4){a=MX3(a,C0[r],C0[r+1]);b=MX3(b,C0[r+2],C0[r+3]);a=MX3(a,C1[r],C1[r+1]);b=MX3(b,C1[r+2],C1[r+3]);} \
      float rm=__builtin_fmaxf(a,b); { auto rr=__builtin_amdgcn_permlane32_swap(__float_as_uint(rm),__float_as_uint(rm),false,false); rm=__builtin_fmaxf(__uint_as_float(rr[0]),__uint_as_float(rr[1])); } \
      resc=false; \
      if(__builtin_expect(__any(rm>(float)THRL),0)){ const float dl=__builtin_fmaxf(rm,0.f); mhat+=dl; \
        _Pragma("unroll") for(int r=0;r<16;++r){C0[r]-=dl;C1[r]-=dl;} \
        const float f=__builtin_amdgcn_exp2f(-dl); l_reg*=f; if(hi==0)wsf[r32]=f; resc=true; } } \
    SBAR(); BLD(GL,P0,P1,(t)+1); SBAR(); \
    GAPB(o[0]=__builtin_amdgcn_mfma_f32_32x32x16_bf16(PAF(0),VFR(0),o[0],0,0,0), C0,0); \
    GAPB(o[1]=__builtin_amdgcn_mfma_f32_32x32x16_bf16(PAF(0),VFR(4),o[1],0,0,0), C0,4); \
    KRD(GL,0); GAPB(o[0]=__builtin_amdgcn_mfma_f32_32x32x16_bf16(PAF(1),VFR(1),o[0],0,0,0), C0,8); \
    KRD(GL,1); GAPB(o[1]=__builtin_amdgcn_mfma_f32_32x32x16_bf16(PAF(1),VFR(5),o[1],0,0,0), C0,12); \
    KRD(GL,2); GAPB(o[0]=__builtin_amdgcn_mfma_f32_32x32x16_bf16(PAF(2),VFR(2),o[0],0,0,0), C1,0); \
    KRD(GL,3); GAPB(o[1]=__builtin_amdgcn_mfma_f32_32x32x16_bf16(PAF(2),VFR(6),o[1],0,0,0), C1,4); \
    GAPB(o[0]=__builtin_amdgcn_mfma_f32_32x32x16_bf16(PAF(3),VFR(3),o[0],0,0,0), C1,8); \
    GAPB(o[1]=__builtin_amdgcn_mfma_f32_32x32x16_bf16(PAF(3),VFR(7),o[1],0,0,0), C1,12); \
    BSUB(GL,P0,P1); SBAR(); \
    }while(0)
  int t=1;
  #undef CMASK
  #define CMASK(P0,P1,t) do{}while(0)
  for(;t+5<NT;t+=2){
    STEP(pB0,pB1,pA0,pA1,t,true,true,true);     WAIT_BAR(2); RESC(); ROT();
    STEP(pA0,pA1,pB0,pB1,t+1,true,true,true);   WAIT_BAR(2); RESC(); ROT();
  }
  #undef CMASK
  #define CMASK(P0,P1,t) do{int jb_=(t)-(NT-4); if(jb_>=0)cmask(P0,P1,jb_,qrel,hi);}while(0)
  #define ENDW(tt) do{ if((tt)+3<NT){WAIT_BAR(2);} else if((tt)+2<NT){WAIT_BAR(1);} else {WAIT_BAR(0);} }while(0)
  for(;t+1<NT;t+=2){
    STEP(pB0,pB1,pA0,pA1,t,(t+3<NT),(t+1<NT),(t+1<NT));       ENDW(t);   RESC(); ROT();
    STEP(pA0,pA1,pB0,pB1,t+1,(t+4<NT),(t+2<NT),(t+2<NT));     ENDW(t+1); RESC(); ROT();
  }
  STEP(pB0,pB1,pA0,pA1,NT-1,false,false,false); RESC();
  { float sacc=pB0[0]+pB0[1]; _Pragma("unroll") for(int r=2;r<16;++r)sacc+=pB0[r]; _Pragma("unroll") for(int r=0;r<16;++r)sacc+=pB1[r]; l_reg+=sacc;
    pw0=(u32x4){PKW(pB0,0),PKW(pB0,2),PKW(pB0,4),PKW(pB0,6)};pw1=(u32x4){PKW(pB0,8),PKW(pB0,10),PKW(pB0,12),PKW(pB0,14)};pw2=(u32x4){PKW(pB1,0),PKW(pB1,2),PKW(pB1,4),PKW(pB1,6)};pw3=(u32x4){PKW(pB1,8),PKW(pB1,10),PKW(pB1,12),PKW(pB1,14)};
    SBAR(); pv(o,vb0+sl_cur,PAF(0),PAF(1),PAF(2),PAF(3)); }
  #undef PKW
  #undef PAF
  #undef VFR
  #undef PIN
  #undef MX3
  #undef GAPA
  #undef GAPB
  #undef EX
  #undef VRD
  #undef KRD
  #undef STEP
  #undef ENDW
  {auto rr=__builtin_amdgcn_permlane32_swap(__float_as_uint(l_reg),__float_as_uint(l_reg),false,false);l_reg=__uint_as_float(rr[0])+__uint_as_float(rr[1]);}
  if(hi==0)wsf[32+r32]=l_reg;asm volatile("s_waitcnt lgkmcnt(0)":::"memory");
  float rli[16];
  #pragma unroll
  for(int r=0;r<16;++r)rli[r]=__builtin_amdgcn_rcpf(wsf[32+crow(r,hi)]);
  bf16*Ow=O+(rowbase+q0+wid*QBLK)*OPITCH+h*D;
  { bf16*stg=(bf16*)(shm+LDS_OST)+wid*2048;
    #pragma unroll
    for(int r=0;r<16;++r){const int orow=crow(r,hi);
      #pragma unroll
      for(int d0=0;d0<2;++d0)stg[orow*64+d0*32+r32]=__float2bfloat16(o[d0][r]*rli[r]);}
    asm volatile("s_waitcnt lgkmcnt(0)":::"memory");
    #pragma unroll
    for(int i=0;i<4;++i){const int row=i*8+(lane>>3),ch=lane&7; const u32x4 v=*(const u32x4*)(stg+row*64+ch*8); ATTN_STORE16(Ow+(long)row*OPITCH+ch*8,v);} }
  asm volatile("s_waitcnt lgkmcnt(0)\n\ts_barrier":::"memory");
  #undef DMA_K
  #undef TOFF
  #undef BLD
  #undef BSUB
  #undef DMA_V
  #undef CMASK
  #undef START
  #undef RESC
  #undef ROT
}
struct AttnTensors { const bf16* Q; const bf16* K; const bf16* V; bf16* O; const float* vb; const int* lov; unsigned* qctr; const unsigned short* U; };
constexpr int NATT=BATCH*NHEAD*NQB, NPOOL=MROW/64, LDS_NXT=LDS_BYTES, LDS_LOV=LDS_BYTES+64;
__device__ __forceinline__ void pool_tile(int p,const unsigned short*U,bf16*O,char*shm){
  typedef __attribute__((address_space(3))) u32x4 lds_v4; typedef __attribute__((address_space(3))) unsigned lds_u32;
  int tid_=threadIdx.x; asm volatile("":"+v"(tid_)); const int tid=tid_;
  const int row0=p*64, b=row0>>13, pos0=16+(row0&(SEQ-1));
  lds_v4* L=(lds_v4*)(__attribute__((address_space(3))) char*)shm;
  u32x4 v[10];
  #pragma unroll
  for(int k=0;k<10;++k){ const int i=tid+512*k; if(i<79*64){ const int r=i>>6,c=i&63,pos=pos0-15+r; const long grow=pos>=16?(long)b*SEQ+(pos-16):(long)MROW+pos; v[k]=__builtin_nontemporal_load((const u32x4*)(U+grow*DM+8*c)); } }
  #pragma unroll
  for(int k=0;k<10;++k){ const int i=tid+512*k; if(i<79*64) L[i]=v[k]; }
  __syncthreads();
  const int cp=tid&255, r0=(tid>>8)*32, w=2<<(cp>>6); const float inv=1.0f/(float)w;
  const lds_u32* Lc=(const lds_u32*)(__attribute__((address_space(3))) char*)shm+cp;
  float s0=0.f,s1=0.f;
  for(int j=1;j<w;++j){ const unsigned x=Lc[(r0+15-j)*256]; s0+=__uint_as_float(x<<16); s1+=__uint_as_float(x&0xffff0000u); }
  unsigned* outp=(unsigned*)(O+(long)(row0+r0)*OPITCH+512+2*cp);
  #pragma unroll 8
  for(int r=0;r<32;++r){ const unsigned x=Lc[(r0+r+15)*256], y=Lc[(r0+r+16-w)*256];
    const float a0=__uint_as_float(x<<16),a1=__uint_as_float(x&0xffff0000u); s0+=a0; s1+=a1;
    outp[(long)r*(OPITCH/2)]=cvtpk_s(s0*inv-a0,s1*inv-a1);
    s0-=__uint_as_float(y<<16); s1-=__uint_as_float(y&0xffff0000u); }
}
template<int THRL,class Extra> __device__ __forceinline__ void attn_phase(char*lds,const AttnTensors&T,int LPITCH,const Extra&X){
  typedef __attribute__((address_space(3))) int lds_int;
  volatile lds_int* nxt=(volatile lds_int*)((__attribute__((address_space(3))) char*)lds+LDS_NXT);
  lds_int* lovl=(lds_int*)((__attribute__((address_space(3))) char*)lds+LDS_LOV);
  for(int i=threadIdx.x;i<NATT;i+=512) lovl[i]=T.lov[i];
  __attribute__((address_space(3))) unsigned short* ordl=(__attribute__((address_space(3))) unsigned short*)((__attribute__((address_space(3))) char*)lds+LDS_LOV+4096);
  lds_int* hb=(lds_int*)((__attribute__((address_space(3))) char*)lds+LDS_LOV+4096+2048);
  lds_int* basel=hb+32*68;
  for(int i=threadIdx.x;i<32*68+68;i+=512) hb[i]=0;
  __syncthreads();
  for(int u=threadIdx.x;u<NATT;u+=512){ const int c=(4*(u&31)+6-lovl[u])>>1; __hip_atomic_fetch_add(&hb[(u>>5)*68+c],1,__ATOMIC_RELAXED,__HIP_MEMORY_SCOPE_WORKGROUP); }
  __syncthreads();
  if(threadIdx.x<68){ int run=0; for(int bh=0;bh<32;++bh){ const int t=hb[bh*68+threadIdx.x]; hb[bh*68+threadIdx.x]=run; run+=t; } basel[threadIdx.x]=run; }
  __syncthreads();
  int higher=0; if(threadIdx.x<68){ for(int c=threadIdx.x+1;c<68;++c) higher+=basel[c]; }
  __syncthreads();
  if(threadIdx.x<68) basel[threadIdx.x]=higher;
  __syncthreads();
  for(int u=threadIdx.x;u<NATT;u+=512){ const int bh=u>>5,qb=u&31,c=(4*qb+6-lovl[u])>>1; int r=basel[c]+hb[bh*68+c];
    for(int q2=0;q2<qb;++q2) r+=(((4*q2+6-lovl[bh*32+q2])>>1)==c)?1:0;
    ordl[r]=(unsigned short)u; }
  __syncthreads();
  int idx=(int)blockIdx.x;
  while(idx<NATT+NPOOL+X.count){
    int fetched=0;
    if(threadIdx.x==0) fetched=(int)__hip_atomic_fetch_add(T.qctr,1u,__ATOMIC_RELAXED,__HIP_MEMORY_SCOPE_AGENT);
    if(idx<NATT){
      const int u_=ordl[idx], qb=u_&31, bh=u_>>5;
      const int lo=__builtin_amdgcn_readfirstlane(lovl[bh*NQB+qb]);
      attn_unit<THRL>(bh/NHEAD,bh%NHEAD,qb,lo,T.vb+(long)bh*LPITCH,T.Q,T.K,T.V,T.O,lds);
    } else if(idx<NATT+NPOOL) pool_tile(idx-NATT,T.U,T.O,lds);
    else X(idx-NATT-NPOOL);
    if(threadIdx.x==0) nxt[0]=fetched;
    asm volatile("s_waitcnt lgkmcnt(0)\n\ts_barrier":::"memory");
    idx=__builtin_amdgcn_readfirstlane(nxt[0]);
    asm volatile("s_waitcnt lgkmcnt(0)\n\ts_barrier":::"memory");
  }
}
constexpr int ATTN_LDS_BYTES=LDS_BYTES+64+4096+2048+(32*68+68)*4;
#undef SBAR
#undef WAIT_BAR
}
constexpr int NB = 4, SEQ = 8192, NMETA = 16, DM = 1024, DA = 512, NH = 8, HD = 64, DFF = 2816, DIN = 2056;
constexpr int MF = NB * SEQ;
constexpr int MP = MF + 256;
constexpr int LSEQ = NMETA + SEQ;
constexpr int LP = 8320;
constexpr float RMS_EPS = 1e-6f;
constexpr float L2E = 1.4426950408889634f;
constexpr float C2 = 0.125f * L2E;
constexpr int NWAVES = 8;
constexpr size_t MiB = 1u << 20;
constexpr size_t WS_CTL = 0, CTL_BYTES = 16384;
constexpr size_t WS_WIN = 1 * MiB;
constexpr size_t WS_WO = 5 * MiB;
constexpr size_t WS_WGU = 7 * MiB;
constexpr size_t WS_WD = 18 * MiB;
constexpr size_t WS_MISC = 24 * MiB;
constexpr size_t WS_LOGF = WS_MISC, WS_CNEG = WS_MISC + 2 * MiB, WS_LOV = WS_MISC + 4 * MiB, WS_SSQ = WS_MISC + 5 * MiB;
constexpr size_t WS_XN = 32 * MiB;
constexpr size_t WS_Q = 100 * MiB;
constexpr size_t WS_QSTRIDE = 33 * MiB;
constexpr size_t WS_A2 = 232 * MiB;
constexpr size_t WS_H = 100 * MiB;
constexpr size_t WS_END = 300 * MiB;
static_assert(WS_XN + (size_t)MP * 1024 * 2 <= WS_Q && WS_Q + 4 * WS_QSTRIDE <= WS_A2 && WS_A2 + (size_t)MF * 1024 * 2 <= WS_END && WS_H + (size_t)MF * DFF * 2 <= WS_END, "ws map");
constexpr int LDS_BYTES = 147456;

#define LAS __attribute__((address_space(3)))
typedef unsigned short bf16;
typedef unsigned v4u __attribute__((ext_vector_type(4)));
typedef float f32x4 __attribute__((ext_vector_type(4)));
__device__ __forceinline__ unsigned f2bf(float f) { unsigned u = __builtin_bit_cast(unsigned, f); return (u + 0x7fffu + ((u >> 16) & 1u)) >> 16; }
__device__ __forceinline__ unsigned pk2(float lo, float hi) { return f2bf(lo) | (f2bf(hi) << 16); }
__device__ __forceinline__ float bf2f(unsigned short b) { return __builtin_bit_cast(float, (unsigned)b << 16); }
__device__ __forceinline__ float sumsq4f(f32x4 x) { return (x[0] * x[0] + x[1] * x[1]) + (x[2] * x[2] + x[3] * x[3]); }
__device__ __forceinline__ float wave_sum(float v) {
#pragma unroll
    for (int o = 1; o < 64; o <<= 1) v += __shfl_xor(v, o);
    return v;
}
__device__ __forceinline__ float wave_max(float v) {
#pragma unroll
    for (int o = 1; o < 64; o <<= 1) v = fmaxf(v, __shfl_xor(v, o));
    return v;
}
__device__ __forceinline__ int pos_row(int b, int pos) { return pos >= NMETA ? b * SEQ + (pos - NMETA) : MF + pos; }

__device__ __forceinline__ void p0_transpose_item(const float* W, int ldw, int k0, int srccol, bf16* WT, int ldwt, int wtrow0, int wtcol0, const float* kscale, LAS float* scr, int lane) {
#pragma unroll
    for (int i = 0; i < 32; ++i) { const int kk = 2 * i + (lane >> 5); float v = __builtin_nontemporal_load(W + (size_t)(k0 + kk) * ldw + srccol + (lane & 31)); if (kscale) v *= kscale[k0 + kk]; scr[kk * 33 + (lane & 31)] = v; }
    asm volatile("s_waitcnt lgkmcnt(0)" ::: "memory");
    const int c = lane & 7;
#pragma unroll
    for (int j = 0; j < 4; ++j) { const int n = (lane >> 3) + 8 * j; const LAS float* s = scr + (8 * c) * 33 + n;
        v4u o; o.x = pk2(s[0 * 33], s[1 * 33]); o.y = pk2(s[2 * 33], s[3 * 33]); o.z = pk2(s[4 * 33], s[5 * 33]); o.w = pk2(s[6 * 33], s[7 * 33]);
        *(v4u*)(WT + (size_t)(wtrow0 + n) * ldwt + wtcol0 + 8 * c) = o; }
    asm volatile("s_waitcnt lgkmcnt(0)" ::: "memory");
}

struct ConvItems {
    static constexpr int I_G = 16 * 88, I_D = 44 * 32, I_F = 4 * 8 * 16, NW_ITEMS = 2 * I_G + I_D + I_F;
    int count; LAS unsigned char* lds;
    const float *w_gate, *w_up, *w_down, *w_out, *w_pool, *pool_scale, *norm2_w; bf16 *Wgu_t, *Wd_t, *Wo_t;
    __device__ __forceinline__ void operator()(int item) const { int tid_ = threadIdx.x; asm volatile("" : "+v"(tid_)); wave_item(item * 8 + __builtin_amdgcn_readfirstlane(tid_ >> 6)); }
    __device__ __forceinline__ void wave_item(int r) const {
        int tid_ = threadIdx.x; asm volatile("" : "+v"(tid_));
        const int lane = tid_ & 63, wave = __builtin_amdgcn_readfirstlane(tid_ >> 6);
        LAS float* scr = (LAS float*)(lds + wave * 8704);
        if (r >= NW_ITEMS) return;
        if (r < I_F) {
            const int g = r >> 7, cb = (r >> 4) & 7, db = r & 15, d = db * 64 + lane, c0 = cb * 16;
            const float* wp = w_pool + ((size_t)g * 128 + c0) * 128;
#pragma unroll 8
            for (int t = 0; t < 32; ++t) { const int idx = t * 64 + lane, c = idx >> 7, j = idx & 127; scr[j * 16 + c] = wp[c * 128 + j] * pool_scale[128 * g + j]; }
            asm volatile("s_waitcnt lgkmcnt(0)" ::: "memory");
            f32x4 a[4];
#pragma unroll
            for (int i = 0; i < 4; ++i) a[i] = (f32x4){0.f, 0.f, 0.f, 0.f};
            const float* wo = w_out + (size_t)(512 + 128 * g) * 1024 + d;
#pragma unroll 16
            for (int j = 0; j < 128; ++j) { const float wv = wo[(size_t)j * 1024]; const LAS f32x4* s4 = (const LAS f32x4*)(scr + j * 16);
#pragma unroll
                for (int i = 0; i < 4; ++i) a[i] += s4[i] * wv; }
            v4u o0, o1; o0.x = pk2(a[0][0], a[0][1]); o0.y = pk2(a[0][2], a[0][3]); o0.z = pk2(a[1][0], a[1][1]); o0.w = pk2(a[1][2], a[1][3]);
            o1.x = pk2(a[2][0], a[2][1]); o1.y = pk2(a[2][2], a[2][3]); o1.z = pk2(a[3][0], a[3][1]); o1.w = pk2(a[3][2], a[3][3]);
            v4u* op = (v4u*)(Wo_t + (size_t)d * 1024 + 512 + 128 * g + c0); op[0] = o0; op[1] = o1;
            asm volatile("s_waitcnt lgkmcnt(0)" ::: "memory");
            return; } r -= I_F;
        if (r < 2 * I_G) { const int up = r >= I_G; if (up) r -= I_G; const int kb = r / 88, nb = r % 88, n0 = 32 * nb;
            p0_transpose_item(up ? w_up : w_gate, DFF, 64 * kb, n0, Wgu_t, 1024, (n0 >> 7) * 256 + (n0 & 127) + (up ? 128 : 0), 64 * kb, norm2_w, scr, lane); return; } r -= 2 * I_G;
        { const int kb = r / 32, nb = r % 32; p0_transpose_item(w_down, 1024, 64 * kb, 32 * nb, Wd_t, DFF, 32 * nb, 64 * kb, nullptr, scr, lane); }
    }
};

#define RLX_AGENT __ATOMIC_RELAXED, __HIP_MEMORY_SCOPE_AGENT
#define XB_TMO      128
#define XB_XCNT(j)  (256  + 64 * (j))
#define XB_XSUB(j)  (1280 + 64 * (j))
#define XB_XGEN(j)  (2304 + 64 * (j))
#define XB_TOP      3328
#define XB_TOPGEN   3392
#define XCD_BAR_WORDS 3456
#define XB_SPIN_CAP (1u << 18)

__device__ __forceinline__ unsigned xb_ld(unsigned* p)              { return __hip_atomic_load(p, __ATOMIC_RELAXED, __HIP_MEMORY_SCOPE_AGENT); }
__device__ __forceinline__ unsigned xb_add(unsigned* p, unsigned v) { return __hip_atomic_fetch_add(p, v, __ATOMIC_RELAXED, __HIP_MEMORY_SCOPE_AGENT); }
__device__ __forceinline__ unsigned xb_xcc_id() { return (unsigned)__builtin_amdgcn_s_getreg((3 << 11) | 20) & 0xFu; }
#define XB_SPIN(cond, bar) do { unsigned _sp = 0; while (cond) { __builtin_amdgcn_s_sleep(1); \
    if ((++_sp & 255u) == 0u) { if (xb_ld(&(bar)[XB_TMO])) break; if (_sp > XB_SPIN_CAP) { atomicAdd(&(bar)[XB_TMO], 1u); break; } } } } while (0)

struct XcdBarrier {
    unsigned* bar; unsigned x;
    volatile LAS unsigned* st;
};

__device__ __forceinline__ XcdBarrier xcd_barrier_post(unsigned* bar, volatile LAS unsigned* st) {
    XcdBarrier b; b.bar = bar; b.x = xb_xcc_id(); b.st = st;
    if (threadIdx.x == 0) (void)xb_add(&bar[XB_XCNT(b.x)], 1u);
    return b;
}
__device__ __forceinline__ void xcd_barrier_complete(unsigned* bar, unsigned x, unsigned& nloc, unsigned& nx) {
    const unsigned G = gridDim.x * gridDim.y * gridDim.z;
    unsigned sum, cnt, mine, sp = 0u;
    for (;;) {
        sum = 0u; cnt = 0u; mine = 0u;
#pragma unroll
        for (unsigned j = 0; j < 16; ++j) { const unsigned c = xb_ld(&bar[XB_XCNT(j)]); sum += c; cnt += (c > 0u) ? 1u : 0u; mine = (j == x) ? c : mine; }
        if (sum == G) break;
        __builtin_amdgcn_s_sleep(1);
        if ((++sp & 255u) == 0u) { if (xb_ld(&bar[XB_TMO])) break; if (sp > XB_SPIN_CAP) { atomicAdd(&bar[XB_TMO], 1u); break; } }
    }
    nloc = mine > 0u ? mine : 1u; nx = cnt > 0u ? cnt : 1u;
}

__device__ __forceinline__ void xcd_barrier(const XcdBarrier& b) {
    asm volatile("s_waitcnt vmcnt(0)" ::: "memory");
    __syncthreads();
    if (threadIdx.x == 0) {
        unsigned* bar = b.bar;
        __builtin_amdgcn_s_waitcnt(0);
        unsigned nloc = b.st[0], nx = b.st[1];
        if (nloc == 0u) { xcd_barrier_complete(bar, b.x, nloc, nx); b.st[0] = nloc; b.st[1] = nx; }
        const unsigned old = xb_add(&bar[XB_XSUB(b.x)], 1u);
        const unsigned gen = old / nloc;
        if (old + 1u == (gen + 1u) * nloc) {
            __builtin_amdgcn_fence(__ATOMIC_RELEASE, "agent");
            asm volatile("s_waitcnt vmcnt(0)" ::: "memory");
            const unsigned og = xb_add(&bar[XB_TOP], 1u);
            const unsigned tg = og / nx;
            if (og + 1u == (tg + 1u) * nx) xb_add(&bar[XB_TOPGEN], 1u);
            else XB_SPIN(xb_ld(&bar[XB_TOPGEN]) == tg, bar);
            __builtin_amdgcn_fence(__ATOMIC_ACQUIRE, "agent");
            xb_add(&bar[XB_XGEN(b.x)], 1u);
            asm volatile("s_waitcnt vmcnt(0)" ::: "memory");
        } else {
            XB_SPIN(xb_ld(&bar[XB_XGEN(b.x)]) == gen, bar);
            __builtin_amdgcn_fence(__ATOMIC_ACQUIRE, "agent");
            asm volatile("s_waitcnt vmcnt(0)" ::: "memory");
        }
    }
    __syncthreads();
}

struct NoExtra { int count; __device__ __forceinline__ void operator()(int) const {} };
#ifndef PROBE_REP
#define PROBE_REP -1
#endif
#define REPS(k) for (int rep_ = 0; rep_ < ((PROBE_REP) == (k) ? 2 : 1); ++rep_)
struct Args { const float* in[14]; float* out; unsigned char* ws; int never; int pad; };

__global__ void __launch_bounds__(NWAVES * 64, 2) hymba_fwd(Args args) {
    extern __shared__ __attribute__((aligned(16))) unsigned char lds_raw[];
    cg::grid_group grid = cg::this_grid();
    LAS unsigned char* lds = (LAS unsigned char*)lds_raw;
    const int tid = threadIdx.x, lane = tid & 63, wave = __builtin_amdgcn_readfirstlane(tid >> 6);
    const int G = gridDim.x, bx = blockIdx.x;
    const int vcu = (G % 8 == 0) ? (bx % 8) * (G / 8) + bx / 8 : bx;
    const int gw = vcu * NWAVES + wave, NGW = G * NWAVES;
    const float* x = args.in[0]; const float* meta = args.in[1]; const float* norm1_w = args.in[2]; const float* w_in = args.in[3]; const float* b_fgate = args.in[4];
    const float* q_norm_w = args.in[5]; const float* k_norm_w = args.in[6]; const float* w_pool = args.in[7]; const float* pool_scale = args.in[8]; const float* w_out = args.in[9];
    const float* norm2_w = args.in[10]; const float* w_gate = args.in[11]; const float* w_up = args.in[12]; const float* w_down = args.in[13];
    float* out = args.out; unsigned char* ws = args.ws;
    volatile LAS unsigned* bst = (volatile LAS unsigned*)(lds + LDS_BYTES - 64);
    if (tid < 2) bst[tid] = 0u;
    __syncthreads();
    const XcdBarrier bar = xcd_barrier_post((unsigned*)(ws + WS_CTL), bst);
    if (args.never) grid.sync();
#define GSYNC() xcd_barrier(bar)
    bf16* Win_t = (bf16*)(ws + WS_WIN); bf16* Wo_t = (bf16*)(ws + WS_WO); bf16* Wgu_t = (bf16*)(ws + WS_WGU); bf16* Wd_t = (bf16*)(ws + WS_WD);
    float* logf_ = (float*)(ws + WS_LOGF); float* cneg = (float*)(ws + WS_CNEG); int* lov = (int*)(ws + WS_LOV); unsigned* qctr = (unsigned*)(ws + WS_LOV + 65536); float* ssq = (float*)(ws + WS_SSQ);
    bf16* XN = (bf16*)(ws + WS_XN); bf16* Qb = (bf16*)(ws + WS_Q); bf16* Kb = (bf16*)(ws + WS_Q + WS_QSTRIDE); bf16* Vb = (bf16*)(ws + WS_Q + 2 * WS_QSTRIDE); bf16* Ub = (bf16*)(ws + WS_Q + 3 * WS_QSTRIDE);
    bf16* A2 = (bf16*)(ws + WS_A2); bf16* Hb = (bf16*)(ws + WS_H);

    REPS(0) {
        if (bx == 0 && tid == 0) { qctr[0] = (unsigned)G; qctr[64] = (unsigned)G; }
        LAS float* scr = (LAS float*)(lds + wave * 8704);
        constexpr int I_QKV = 16 * 48, I_U = 16 * 16, I_O = 8 * 32;
        for (int it = gw; it < I_QKV + I_U + I_O; it += NGW) {
            int r = it;
            if (r < I_QKV) { const int kb = r / 48, nb = r % 48; p0_transpose_item(w_in, DIN, 64 * kb, 32 * nb, Win_t, 1024, 32 * nb, 64 * kb, nullptr, scr, lane); continue; } r -= I_QKV;
            if (r < I_U) { const int kb = r / 16, nb = r % 16; p0_transpose_item(w_in, DIN, 64 * kb, 1544 + 32 * nb, Win_t, 1024, 1536 + 32 * nb, 64 * kb, nullptr, scr, lane); continue; } r -= I_U;
            { const int kb = r / 32, nb = r % 32; p0_transpose_item(w_out, 1024, 64 * kb, 32 * nb, Wo_t, 1024, 32 * nb, 64 * kb, nullptr, scr, lane); }
        }
        {
            LAS f32x4* wft = (LAS f32x4*)(lds + 73728);
            for (int k = tid; k < DM; k += NWAVES * 64) { const float s = norm1_w[k]; const f32x4 a = *(const f32x4*)(w_in + (size_t)k * DIN + 1536) * s, b = *(const f32x4*)(w_in + (size_t)k * DIN + 1540) * s;
                const int e = ((4 * (k >> 8) + (k & 3)) * 2) * 64 + ((k & 255) >> 2); wft[e] = a; wft[e + 64] = b; }
            __syncthreads();
            f32x4 nw[4];
#pragma unroll
            for (int j = 0; j < 4; ++j) nw[j] = *(const f32x4*)(norm1_w + 4 * lane + 256 * j);
            const float bfg = b_fgate[lane & 7];
            f32x4 vn[4], vn2[4];
            { const int m = gw; const float* xrow = m < MF ? x + (size_t)m * DM : meta + (size_t)(m - MF) * DM;
#pragma unroll
              for (int j = 0; j < 4; ++j) vn[j] = __builtin_nontemporal_load((const f32x4*)(xrow + 4 * lane + 256 * j));
              const int m2 = gw + NGW; if (m2 < MF + NMETA) { const float* xrow2 = m2 < MF ? x + (size_t)m2 * DM : meta + (size_t)(m2 - MF) * DM;
#pragma unroll
                for (int j = 0; j < 4; ++j) vn2[j] = __builtin_nontemporal_load((const f32x4*)(xrow2 + 4 * lane + 256 * j)); } }
            for (int m = gw; m < MF + NMETA; m += NGW) {
                f32x4 v[4]; float ss = 0.f;
#pragma unroll
                for (int j = 0; j < 4; ++j) { v[j] = vn[j]; vn[j] = vn2[j]; ss += sumsq4f(v[j]); }
                { const int mn = m + 2 * NGW; if (mn < MF + NMETA) { const float* xrow = mn < MF ? x + (size_t)mn * DM : meta + (size_t)(mn - MF) * DM;
#pragma unroll
                    for (int j = 0; j < 4; ++j) vn2[j] = __builtin_nontemporal_load((const f32x4*)(xrow + 4 * lane + 256 * j)); } }
                const float rstd = 1.0f / sqrtf(wave_sum(ss) * (1.0f / DM) + RMS_EPS);
                unsigned long long* o8 = (unsigned long long*)(XN + (size_t)m * DM) + lane;
#pragma unroll
                for (int j = 0; j < 4; ++j) { const f32x4 y = v[j] * rstd * nw[j]; o8[64 * j] = (unsigned long long)pk2(y[0], y[1]) | ((unsigned long long)pk2(y[2], y[3]) << 32); }
                f32x4 a0 = {0.f, 0.f, 0.f, 0.f}, a1 = {0.f, 0.f, 0.f, 0.f};
#pragma unroll
                for (int j = 0; j < 4; ++j)
#pragma unroll
                    for (int i = 0; i < 4; ++i) { a0 += wft[((4 * j + i) * 2) * 64 + lane] * v[j][i]; a1 += wft[((4 * j + i) * 2 + 1) * 64 + lane] * v[j][i]; }
                float fgsel = 0.f;
#pragma unroll
                for (int h = 0; h < 8; ++h) { const float a = wave_sum(h < 4 ? a0[h & 3] : a1[h & 3]); if ((lane & 7) == h) fgsel = a; }
                const float z = fgsel * rstd + bfg;
                const float lf = fminf(z, 0.f) - log1pf(expf(-fabsf(z)));
                if (lane < 8) {
                    if (m < MF) { const int b = m >> 13, t = m & (SEQ - 1); logf_[(size_t)(b * NH + lane) * LP + NMETA + t] = lf; }
                    else { for (int b = 0; b < NB; ++b) logf_[(size_t)(b * NH + lane) * LP + (m - MF)] = lf; }
                }
            }
        }
        GSYNC();
    }

    REPS(1) {
    for (int hh = bx; hh < 24; hh += G) {
        typedef short bf16x8_t __attribute__((ext_vector_type(8)));
        const int fr = lane & 15, fq = lane >> 4, nbase = 512 + 64 * hh;
        f32x4 acc4[4];
#pragma unroll
        for (int nb = 0; nb < 4; ++nb) acc4[nb] = (f32x4){0.f, 0.f, 0.f, 0.f};
#pragma unroll
        for (int s_ = 0; s_ < 4; ++s_) { const int k0 = 128 * wave + 32 * s_ + 8 * fq;
            const bf16x8_t av = *(const bf16x8_t*)(XN + (size_t)(MF + fr) * DM + k0);
#pragma unroll
            for (int nb = 0; nb < 4; ++nb) { const bf16x8_t bv = *(const bf16x8_t*)(Win_t + (size_t)(nbase + 16 * nb + fr) * DM + k0); acc4[nb] = __builtin_amdgcn_mfma_f32_16x16x32_bf16(bv, av, acc4[nb], 0, 0, 0); } }
        LAS float* part = (LAS float*)lds;
#pragma unroll
        for (int nb = 0; nb < 4; ++nb)
#pragma unroll
            for (int j = 0; j < 4; ++j) part[(wave * 16 + fr) * 64 + 16 * nb + 4 * fq + j] = acc4[nb][j];
        __syncthreads();
        const int row = tid >> 5, c = 2 * (tid & 31);
        float v0 = 0.f, v1 = 0.f;
#pragma unroll
        for (int w = 0; w < 8; ++w) { v0 += part[(w * 16 + row) * 64 + c]; v1 += part[(w * 16 + row) * 64 + c + 1]; }
        bf16* dstb = hh < 8 ? Kb : (hh < 16 ? Vb : Ub); const int colb = 64 * (hh & 7);
        if (hh < 8) { float ss = v0 * v0 + v1 * v1;
#pragma unroll
            for (int o = 1; o < 32; o <<= 1) ss += __shfl_xor(ss, o);
            const float rs = 1.0f / sqrtf(ss * (1.0f / 64.0f) + RMS_EPS); v0 *= rs * k_norm_w[c]; v1 *= rs * k_norm_w[c + 1]; }
        *(unsigned*)(dstb + (size_t)(MF + row) * 512 + colb + c) = pk2(v0, v1);
        for (int i = tid; i < 48 * 32; i += NWAVES * 64) *(unsigned*)(dstb + (size_t)(MF + 16 + (i >> 5)) * 512 + colb + 2 * (i & 31)) = 0u;
        __syncthreads();
    }
    if (bx >= G - NB * NH && G >= NB * NH) {
        const int bh = bx - (G - NB * NH);
        LAS float* buf = (LAS float*)lds; LAS float* wtot = (LAS float*)(lds + 36864);
        const float* src = logf_ + (size_t)bh * LP;
        for (int i = tid; i < 8704; i += 512) buf[i] = i < LSEQ ? src[i] : 0.f;
        __syncthreads();
        float s = 0.f;
#pragma unroll
        for (int i = 0; i < 17; ++i) s += buf[17 * tid + i];
        float inc = s;
#pragma unroll
        for (int o = 1; o < 64; o <<= 1) { const float t = __shfl_up(inc, o); if (lane >= o) inc += t; }
        if (lane == 63) wtot[wave] = inc;
        __syncthreads();
        float run = inc - s;
        for (int w = 0; w < wave; ++w) run += wtot[w];
#pragma unroll
        for (int i = 0; i < 17; ++i) { run += buf[17 * tid + i]; buf[17 * tid + i] = -L2E * run; }
        __syncthreads();
        float* dst = cneg + (size_t)bh * LP;
        for (int i = tid; i < LP; i += 512) dst[i] = i < NMETA ? buf[i] : (i < 128 ? -INFINITY : buf[i - 112]);
        if (tid < 32) {
            float mq = 0.f, mk = 0.f;
            for (int i = 0; i < 64; ++i) { mq = fmaxf(mq, fabsf(q_norm_w[i])); mk = fmaxf(mk, fabsf(k_norm_w[i])); }
            const float T2 = 2.0f * (L2E * 8.0f * mq * mk) + 24.0f;
            const int qb = tid, NT = 2 + 4 * (qb + 1); const float ref = buf[NMETA + 256 * qb];
            int lo = 0;
            if (buf[NMETA - 1] - ref < -T2) { int v = 2, hi_ = NT - 4;
                while (v < hi_) { const int mid = (v + hi_) >> 1; if (buf[NMETA + 64 * (mid - 2) + 63] - ref < -T2) v = mid + 1; else hi_ = mid; }
                lo = v & ~1; }
            lov[bh * 32 + qb] = lo;
        }
        __syncthreads();
    }
    {
        pg8::Gemm g{XN, Win_t, MF, 2048, 1024}; pg8::StaticOrder S; S.init(MF, 2048, G, bx);
        LAS float* nwl = (LAS float*)(lds + 131072);
        if (tid < 128) nwl[tid] = tid < 64 ? q_norm_w[tid] * C2 : k_norm_w[tid - 64];
        __syncthreads();
        pg8::EpiQKVU E{Qb, Kb, Vb, Ub, nwl};
        pg8::gemm_phase<pg8::EpiQKVU, pg8::StaticOrder, true, true>(lds, g, S, E);
    }
    GSYNC();
    }

    REPS(2) {
    {
        static_assert(attn_body::ATTN_LDS_BYTES <= LDS_BYTES, "attention LDS");
        const attn_body::AttnTensors AT{(const attn_body::bf16*)Qb, (const attn_body::bf16*)Kb, (const attn_body::bf16*)Vb, (attn_body::bf16*)A2, cneg, lov, qctr + 64 * rep_, (const unsigned short*)Ub};
        ConvItems CI{(ConvItems::NW_ITEMS + 7) / 8, lds, w_gate, w_up, w_down, w_out, w_pool, pool_scale, norm2_w, Wgu_t, Wd_t, Wo_t};
        if (gw < ConvItems::I_F && NGW > 2 * ConvItems::I_F) { CI.wave_item(gw); CI.wave_item(ConvItems::I_F + gw); }
        else if (NGW > 2 * ConvItems::I_F) { for (int r = 2 * ConvItems::I_F + (gw - ConvItems::I_F); r < ConvItems::NW_ITEMS; r += NGW - ConvItems::I_F) CI.wave_item(r); }
        else { for (int r = gw; r < ConvItems::NW_ITEMS; r += NGW) CI.wave_item(r); }
        __syncthreads();
        const NoExtra NX{0};
        attn_body::attn_phase<32, NoExtra>((char*)lds_raw, AT, LP, NX);
    }
    GSYNC();
    }

    REPS(3) {
        pg8::Gemm g{A2, Wo_t, MF, 1024, 1024}; pg8::StaticOrder S; S.init(MF, 1024, G, bx);
        pg8::EpiRes1 E{x, out, XN, ssq};
        pg8::gemm_phase<pg8::EpiRes1, pg8::StaticOrder, true, true>(lds, g, S, E);
        GSYNC();
    }
    REPS(4) {
        pg8::Gemm g{XN, Wgu_t, MF, 2 * DFF, 1024}; pg8::StaticOrder S; S.init(MF, 2 * DFF, G, bx);
        LAS float* rstd_lds = (LAS float*)(lds + 131072);
        int pmA = -1, pmB = -1; bool many = false; { pg8::Unit u_; for (int i_ = 0; S.next(i_, u_); ++i_) { if (pmA < 0) pmA = u_.pm; if (u_.pm != pmA) { if (pmB < 0) pmB = u_.pm; else if (u_.pm != pmB) many = true; } } }
        if (pmA >= 0) { const int pm_ = (tid < 256 || pmB < 0) ? pmA : pmB; const f32x4* sp = (const f32x4*)(ssq + ((size_t)pm_ * 256 + (tid & 255)) * 16); const f32x4 s0 = sp[0], s1 = sp[1], s2 = sp[2], s3 = sp[3];
            const float tot = (((s0[0] + s0[1]) + (s0[2] + s0[3])) + ((s1[0] + s1[1]) + (s1[2] + s1[3]))) + (((s2[0] + s2[1]) + (s2[2] + s2[3])) + ((s3[0] + s3[1]) + (s3[2] + s3[3])));
            rstd_lds[tid] = 1.0f / sqrtf(tot * (1.0f / 1024.0f) + RMS_EPS); }
        __syncthreads();
        pg8::EpiSwiGLU E{Hb, rstd_lds, pmA, many ? ssq : nullptr};
        pg8::gemm_phase<pg8::EpiSwiGLU, pg8::StaticOrder, true, true>(lds, g, S, E);
        GSYNC();
    }
    {
        pg8::Gemm g{Hb, Wd_t, MF, 1024, DFF}; pg8::StaticOrder S; S.init(MF, 1024, G, bx);
        pg8::EpiRes2 E{out, XN};
        pg8::gemm_phase<pg8::EpiRes2, pg8::StaticOrder, true, true>(lds, g, S, E);
    }
}

extern "C" void kernel_launch(void* const* d_in, const int* in_sizes, int n_in, void* d_out, int out_size, void* d_ws, size_t ws_size, hipStream_t stream) {
    static int grid = 0;
    if (grid == 0) {
        if (n_in != 14 || in_sizes[0] != MF * DM || out_size != MF * DM || ws_size < WS_END) { fprintf(stderr, "kernel_launch: unexpected shapes (n_in %d, in0 %d, out %d, ws %zu); nothing launched\n", n_in, n_in > 0 ? in_sizes[0] : -1, out_size, ws_size); grid = -1; return; }
        int dev = 0, cus = 0, per_cu = 0;
        hipGetDevice(&dev); hipDeviceGetAttribute(&cus, hipDeviceAttributeMultiprocessorCount, dev);
        if (hipFuncSetAttribute((const void*)hymba_fwd, hipFuncAttributeMaxDynamicSharedMemorySize, LDS_BYTES) != hipSuccess) { fprintf(stderr, "kernel_launch: hipFuncSetAttribute failed\n"); }
        if (hipOccupancyMaxActiveBlocksPerMultiprocessor(&per_cu, (const void*)hymba_fwd, NWAVES * 64, LDS_BYTES) != hipSuccess || per_cu < 1) { fprintf(stderr, "kernel_launch: occupancy query says %d blocks per CU\n", per_cu); per_cu = 1; }
        (void)hipGetLastError();
        grid = cus * per_cu;
    }
    if (grid < 0) return;
    if (hipMemsetAsync((char*)d_ws + WS_CTL, 0, CTL_BYTES, stream) != hipSuccess) { fprintf(stderr, "kernel_launch: hipMemsetAsync failed\n"); return; }
    Args a{};
    for (int i = 0; i < 14; ++i) a.in[i] = (const float*)d_in[i];
    a.out = (float*)d_out; a.ws = (unsigned char*)d_ws;
    void* kargs[] = {&a};
    hipError_t e = hipLaunchCooperativeKernel((const void*)hymba_fwd, dim3(grid), dim3(NWAVES * 64), kargs, LDS_BYTES, stream);
    if (e != hipSuccess) fprintf(stderr, "kernel_launch: cooperative launch failed: %s (grid %d)\n", hipGetErrorString(e), grid);
}
```
